# Optimizing an MI355X kernel written in HIP

```python
import math
import jax, jax.numpy as jnp
from jax import lax
import numpy as np

D_MODEL = 1024
BATCH = 8
SEQ = 4096
DEPTH = 2

CHUNK = 64
Q_BLOCK = 128
CONV_DIM = D_MODEL // 2
CONV_WIDTH = 3
HG_HEADS = 4
HG_DK = 128
HG_DV = (D_MODEL // 2) // HG_HEADS
HG_FDIM = HG_HEADS * HG_DK
HG_WIDTH = HG_HEADS * HG_DV
SB_HEADS = 16
SB_HEAD_DIM = D_MODEL // SB_HEADS
SB_WIDTH = SB_HEADS * SB_HEAD_DIM
D_FF = 4 * D_MODEL
N_EVEN = (DEPTH + 1) // 2
N_ODD = DEPTH // 2
AB_IN = 3 * CONV_DIM + 2 * HG_FDIM + 2 * HG_WIDTH
AB_MIX = CONV_DIM + HG_WIDTH
AB_SPLITS = [CONV_DIM, 2 * CONV_DIM, 3 * CONV_DIM,
             3 * CONV_DIM + HG_FDIM, 3 * CONV_DIM + 2 * HG_FDIM,
             3 * CONV_DIM + 2 * HG_FDIM + HG_WIDTH]
EPS = 1e-6

kernel_name = "hybrid_chunk_causal_conv_hgrn2_stickbreak"


def rms_norm(x, g):
    xf = x.astype(jnp.float32)
    y = xf * lax.rsqrt(jnp.mean(xf * xf, axis=-1, keepdims=True) + EPS)
    return (y * g.astype(jnp.float32)).astype(x.dtype)


def causal_depthwise_conv(u, w):
    width, ch = w.shape
    return lax.conv_general_dilated(
        u, w[:, None, :], window_strides=(1,), padding=[(width - 1, 0)],
        dimension_numbers=('NWC', 'WIO', 'NWC'), feature_group_count=ch)


def hgrn2_chunkwise(q, k, v, log_f):
    B, S, H, Dk = q.shape
    Dv = v.shape[-1]
    n = S // CHUNK

    def to_chunks(t):
        return t.reshape(B, n, CHUNK, H, t.shape[-1]).transpose(1, 0, 3, 2, 4)

    qc, kc, vc, gc = to_chunks(q), to_chunks(k), to_chunks(v), to_chunks(log_f)
    bc = jnp.cumsum(gc, axis=3)
    causal = jnp.tril(jnp.ones((CHUNK, CHUNK), dtype=bool))

    def step(state, inp):
        q_, k_, v_, b_ = inp
        inter = jnp.einsum('bhtk,bhkv->bhtv', q_ * jnp.exp(b_), state)
        diff = jnp.where(causal[None, None, :, :, None],
                         b_[:, :, :, None, :] - b_[:, :, None, :, :], -jnp.inf)
        decay = jnp.exp(diff)
        scores = jnp.einsum('bhtk,bhsk,bhtsk->bhts', q_, k_, decay)
        intra = jnp.einsum('bhts,bhsv->bhtv', scores, v_)
        b_last = b_[:, :, -1:, :]
        new_state = (jnp.exp(b_last[:, :, 0, :])[..., None] * state
                     + jnp.einsum('bhsk,bhsv->bhkv', k_ * jnp.exp(b_last - b_), v_))
        return new_state, inter + intra

    init = jnp.zeros((B, H, Dk, Dv), jnp.float32)
    _, out = lax.scan(step, init, (qc, kc, vc, bc))
    return out.transpose(1, 0, 3, 2, 4).reshape(B, S, H, Dv)


def stick_breaking_attention(q, k, v):
    S = q.shape[2]
    scale = SB_HEAD_DIM ** -0.5
    outs = []
    for blk in range(S // Q_BLOCK):
        q0 = blk * Q_BLOCK
        end = q0 + Q_BLOCK
        qb = q[:, :, q0:end]
        kb = k[:, :, :end]
        vb = v[:, :, :end]
        z = jnp.einsum('bhqd,bhkd->bhqk', qb, kb) * scale
        qpos = q0 + jnp.arange(Q_BLOCK)
        kpos = jnp.arange(end)
        mask = (kpos[None, :] < qpos[:, None])[None, None]
        log_beta = jax.nn.log_sigmoid(z)
        log_one_minus = jnp.where(mask, log_beta - z, 0.0)
        later = lax.cumsum(log_one_minus, axis=3, reverse=True) - log_one_minus
        w = jnp.where(mask, jnp.exp(log_beta + later), 0.0)
        outs.append(jnp.einsum('bhqk,bhkd->bhqd', w, vb))
    return jnp.concatenate(outs, axis=2)


def mixer_conv_hgrn(h, w_in, conv_w, hg_norm, lower_bound, w_out):
    B, S, _ = h.shape
    u = h @ w_in
    a_b, a_c, a_h, hq, hf, hi, hg = jnp.split(u, AB_SPLITS, axis=-1)
    y_a = a_b * causal_depthwise_conv(a_c * a_h, conv_w)
    f = lower_bound + (1.0 - lower_bound) * jax.nn.sigmoid(hf.astype(jnp.float32))
    log_f = jnp.log(f)
    k_in = 1.0 - f
    heads_k = lambda t: t.reshape(B, S, HG_HEADS, HG_DK)
    o = hgrn2_chunkwise(heads_k(hq.astype(jnp.float32)), heads_k(k_in),
                        hi.astype(jnp.float32).reshape(B, S, HG_HEADS, HG_DV), heads_k(log_f))
    o = rms_norm(o, hg_norm.reshape(HG_HEADS, HG_DV))
    y_b = (o.reshape(B, S, HG_WIDTH) * jax.nn.silu(hg.astype(jnp.float32))).astype(h.dtype)
    return jnp.concatenate([y_a, y_b], axis=-1) @ w_out


def mixer_stick_breaking(h, w_qkv, q_norm, k_norm, w_out):
    B, S, _ = h.shape
    qkv = (h @ w_qkv).reshape(B, S, 3, SB_HEADS, SB_HEAD_DIM)
    q = rms_norm(qkv[:, :, 0], q_norm)
    k = rms_norm(qkv[:, :, 1], k_norm)
    v = qkv[:, :, 2]
    to_bhsd = lambda t: t.astype(jnp.float32).transpose(0, 2, 1, 3)
    o = stick_breaking_attention(to_bhsd(q), to_bhsd(k), to_bhsd(v))
    o = o.transpose(0, 2, 1, 3).reshape(B, S, SB_WIDTH).astype(h.dtype)
    return o @ w_out


def setup_inputs(seed: int = 0) -> dict:
    key = jax.random.key(seed)
    ks = jax.random.split(key, 20)
    nrm = lambda k, shape, s: jax.random.normal(k, shape, jnp.float32) * s
    gain = lambda k, shape: 1.0 + 0.02 * jax.random.normal(k, shape, jnp.float32)
    return {
        "x": nrm(ks[0], (BATCH, SEQ, D_MODEL), 1.0),
        "c": nrm(ks[1], (BATCH, D_MODEL), 1.0),
        "ada_w": nrm(ks[2], (DEPTH, D_MODEL, 6 * D_MODEL), 0.5 * D_MODEL ** -0.5),
        "ada_b": nrm(ks[3], (DEPTH, 6 * D_MODEL), 0.02),
        "norm_mix": gain(ks[4], (DEPTH, D_MODEL)),
        "norm_mlp": gain(ks[5], (DEPTH, D_MODEL)),
        "w_in_ab": nrm(ks[6], (N_EVEN, D_MODEL, AB_IN), D_MODEL ** -0.5),
        "conv_w": nrm(ks[7], (N_EVEN, CONV_WIDTH, CONV_DIM), CONV_WIDTH ** -0.5),
        "hg_norm": gain(ks[8], (N_EVEN, HG_WIDTH)),
        "lb_logits": nrm(ks[9], (DEPTH + 1, HG_FDIM), 0.1),
        "w_out_ab": nrm(ks[10], (N_EVEN, AB_MIX, D_MODEL), AB_MIX ** -0.5),
        "w_qkv": nrm(ks[11], (N_ODD, D_MODEL, 3 * SB_WIDTH), D_MODEL ** -0.5),
        "q_norm": gain(ks[12], (N_ODD, SB_HEAD_DIM)),
        "k_norm": gain(ks[13], (N_ODD, SB_HEAD_DIM)),
        "w_out_c": nrm(ks[14], (N_ODD, SB_WIDTH, D_MODEL), SB_WIDTH ** -0.5),
        "mlp_w1": nrm(ks[15], (DEPTH, D_MODEL, D_FF), D_MODEL ** -0.5),
        "mlp_w2": nrm(ks[16], (DEPTH, D_FF, D_MODEL), D_FF ** -0.5),
    }


def reference(x, c, ada_w, ada_b, norm_mix, norm_mlp, w_in_ab, conv_w, hg_norm,
              lb_logits, w_out_ab, w_qkv, q_norm, k_norm, w_out_c, mlp_w1, mlp_w2):
    c_act = jax.nn.silu(c)
    lower_bounds = jnp.cumsum(jax.nn.softmax(lb_logits.astype(jnp.float32), axis=0), axis=0)
    for layer in range(DEPTH):
        mod = c_act @ ada_w[layer] + ada_b[layer]
        shift1, scale1, gate1, shift2, scale2, gate2 = jnp.split(mod[:, None, :], 6, axis=-1)
        h = rms_norm(x, norm_mix[layer]) * (1.0 + scale1) + shift1
        j = layer // 2
        if layer % 2 == 0:
            y = mixer_conv_hgrn(h, w_in_ab[j], conv_w[j], hg_norm[j],
                                lower_bounds[layer], w_out_ab[j])
        else:
            y = mixer_stick_breaking(h, w_qkv[j], q_norm[j], k_norm[j], w_out_c[j])
        x = x + gate1 * y
        h = rms_norm(x, norm_mlp[layer]) * (1.0 + scale2) + shift2
        x = x + gate2 * (jnp.square(jax.nn.relu(h @ mlp_w1[layer])) @ mlp_w2[layer])
    return x
```

```cpp
#include <hip/hip_runtime.h>
#include <hip/hip_cooperative_groups.h>
#include <cstdio>
#include <cstdint>
namespace cg = cooperative_groups;
namespace pg8 {
#define PG8_LAS __attribute__((address_space(3)))
typedef unsigned short bf16_t;
typedef short bf16x8 __attribute__((ext_vector_type(8)));
typedef float f32x4 __attribute__((ext_vector_type(4)));
typedef unsigned u32x4 __attribute__((ext_vector_type(4)));
constexpr int BM = 256, BK = 64, HALF = 128, HTB = HALF * BK * 2  , STAGE_BYTES = 8 * HTB, NXCD = 8, WGM = 8;

__host__ __device__ __forceinline__ int lds_byte(int r, int c) { const int st = (r >> 4) * 2 + (c >> 5), rr = r & 15, cc = c & 31, ob = rr * 64 + cc * 2; return st * 1024 + (ob ^ (((ob >> 9) & 1) << 5)); }
__host__ __device__ __forceinline__ void stage_rc(int b, int& R, int& C) { const int st = b / 1024, sb = b % 1024, swz = sb ^ (((sb >> 9) & 1) << 5); R = (st >> 1) * 16 + swz / 64; C = (st & 1) * 32 + (swz % 64) / 2; }
__host__ __device__ __forceinline__ int perm32(int rho) { const int n = rho >> 4, i = rho & 15; return 8 * (i >> 2) + 4 * n + (i & 3); }

struct Unit { int pm, pn; };
struct Gemm { const bf16_t* A; const bf16_t* Bt; int M, N, K; };

struct StaticOrder {
    int nM, nN, nwg, G, c;
    __host__ __device__ void init(int M, int N, int G_, int c_) { nM = M / BM; nN = N / BM; nwg = nM * nN; G = G_; c = c_; }
    __host__ __device__ bool next(int i, Unit& u) const {
        const long L = (long)i * G + c; if (L >= nwg) return false;
        int wgid = (int)L; { const int q = nwg / NXCD, r = nwg % NXCD, xcd = wgid % NXCD, off = wgid / NXCD; wgid = (xcd < r ? xcd * (q + 1) : r * (q + 1) + (xcd - r) * q) + off; }
        const int nig = WGM * nN, gid = wgid / nig, fm = gid * WGM, gsz = (nM - fm) < WGM ? (nM - fm) : WGM;
        u.pm = fm + ((wgid % nig) % gsz); u.pn = (wgid % nig) / gsz; return true;
    }
    __device__ __forceinline__ void a_ready(const Unit&) const {}
    __device__ __forceinline__ void done(const Unit&) const {}
};

__device__ __forceinline__ unsigned cvt_pk_bf16(float lo, float hi) { unsigned r; asm volatile("v_cvt_pk_bf16_f32 %0, %1, %2" : "=v"(r) : "v"(lo), "v"(hi)); return r; }
typedef float f32x2 __attribute__((ext_vector_type(2)));
__device__ __forceinline__ f32x2 relu2_pk(f32x2 v) { f32x2 r; r.x = fmaxf(v.x, 0.f); r.y = fmaxf(v.y, 0.f); return r * r; }

template <int ACT  > struct EpiBf16 {
    static constexpr bool PERM = true, AFTER_DRAIN = false; static_assert(ACT == 0 || ACT == 1, "EpiBf16: ACT is 0 or 1");
    bf16_t* O; int ldc; const float* bias; int bias_bstride; const float* ssq; float eps;
    __device__ __forceinline__ void operator()(const f32x4 (&acc)[2][2][4][2], const Unit& u, int wr, int wc, int fr, int fq) const {
        const int row0 = u.pm * BM + wr * 64 + fr; const int colt = u.pn * BM; bf16_t* base = O;
        const int col0 = colt + wc * 32 + 8 * fq;
        const float* bb = bias ? bias + (size_t)(u.pm >> 4) * bias_bstride : nullptr;
        f32x4 bv[2][2];
#pragma unroll
        for (int bj = 0; bj < 2; ++bj)
#pragma unroll
            for (int n = 0; n < 2; ++n) bv[bj][n] = bb ? *(const f32x4*)(bb + col0 + bj * HALF + 4 * n) : (f32x4){0.f, 0.f, 0.f, 0.f};
        float rsv[2][4];
#pragma unroll
        for (int ai = 0; ai < 2; ++ai)
#pragma unroll
            for (int m = 0; m < 4; ++m) rsv[ai][m] = ssq ? ssq[row0 + ai * HALF + m * 16] : 0.f;
#pragma unroll
        for (int ai = 0; ai < 2; ++ai)
#pragma unroll
            for (int m = 0; m < 4; ++m) { const int row = row0 + ai * HALF + m * 16; bf16_t* rowp = base + (size_t)row * ldc + col0;
                float rs = 1.0f;
                if (ssq) rs = rsqrtf(rsv[ai][m] * (1.0f / 1024.0f) + eps);
#pragma unroll
                for (int bj = 0; bj < 2; ++bj) { f32x4 v0 = acc[ai][bj][m][0] * rs + bv[bj][0], v1 = acc[ai][bj][m][1] * rs + bv[bj][1];
                    if (ACT == 1) { f32x2 a = relu2_pk((f32x2){v0[0], v0[1]}), b = relu2_pk((f32x2){v0[2], v0[3]}), c = relu2_pk((f32x2){v1[0], v1[1]}), d = relu2_pk((f32x2){v1[2], v1[3]});
                        v0 = (f32x4){a.x, a.y, b.x, b.y}; v1 = (f32x4){c.x, c.y, d.x, d.y}; }
                    u32x4 w; w.x = cvt_pk_bf16(v0[0], v0[1]); w.y = cvt_pk_bf16(v0[2], v0[3]); w.z = cvt_pk_bf16(v1[0], v1[1]); w.w = cvt_pk_bf16(v1[2], v1[3]);
                    *(u32x4*)(rowp + bj * HALF) = w; } }
    }
};

struct EpiQKV {
    static constexpr bool PERM = true, AFTER_DRAIN = false;
    bf16_t* O; size_t split_stride; const float* qg; const float* kg; float eps; const float* bias; int bias_bstride; const float* ssq;
    __device__ __forceinline__ void operator()(const f32x4 (&acc)[2][2][4][2], const Unit& u, int wr, int wc, int fr, int fq) const {
        const int t = u.pn >> 2, head = (u.pn & 3) * 4 + wc;
        bf16_t* base = O + (size_t)t * split_stride + head * 64 + 8 * fq;
        const int row0 = u.pm * BM + wr * 64 + fr;
        f32x4 gv[2][2];
        const float* gsrc = (t == 0) ? qg : kg;
#pragma unroll
        for (int bj = 0; bj < 2; ++bj)
#pragma unroll
            for (int n = 0; n < 2; ++n) gv[bj][n] = (t < 2) ? *(const f32x4*)(gsrc + 32 * bj + 8 * fq + 4 * n) : (f32x4){1.f, 1.f, 1.f, 1.f};
        const float qs = (t == 0) ? 0.125f * 1.4426950408889634f : 1.0f;
        const float* bb = bias + (size_t)(u.pm >> 4) * bias_bstride + u.pn * BM + wc * 32 + 8 * fq;
        f32x4 bv[2][2];
#pragma unroll
        for (int bj = 0; bj < 2; ++bj)
#pragma unroll
            for (int n = 0; n < 2; ++n) bv[bj][n] = *(const f32x4*)(bb + bj * HALF + 4 * n);
        float rsv[2][4];
#pragma unroll
        for (int ai = 0; ai < 2; ++ai)
#pragma unroll
            for (int m = 0; m < 4; ++m) rsv[ai][m] = ssq[row0 + ai * HALF + m * 16];
#pragma unroll
        for (int ai = 0; ai < 2; ++ai)
#pragma unroll
            for (int m = 0; m < 4; ++m) {
                float rs;
                rs = rsqrtf(rsv[ai][m] * (1.0f / 1024.0f) + eps);
                f32x4 xv[2][2];
#pragma unroll
                for (int bj = 0; bj < 2; ++bj)
#pragma unroll
                    for (int n = 0; n < 2; ++n) xv[bj][n] = acc[ai][bj][m][n] * rs + bv[bj][n];
                float sc = 1.0f;
                if (t < 2) { float ss = 0.f;
#pragma unroll
                    for (int bj = 0; bj < 2; ++bj)
#pragma unroll
                        for (int n = 0; n < 2; ++n) { const f32x4 x = xv[bj][n]; ss += (x[0] * x[0] + x[1] * x[1]) + (x[2] * x[2] + x[3] * x[3]); }
                    ss += __shfl_xor(ss, 16); ss += __shfl_xor(ss, 32);
                    sc = rsqrtf(ss * (1.0f / 64.0f) + eps) * qs; }
                const int row = row0 + ai * HALF + m * 16;
                if (t < 2) {
                    bf16_t* rowp = base + (size_t)row * 1024;
#pragma unroll
                    for (int bj = 0; bj < 2; ++bj) { const f32x4 v0 = xv[bj][0] * sc * gv[bj][0], v1 = xv[bj][1] * sc * gv[bj][1];
                        u32x4 w; w.x = cvt_pk_bf16(v0[0], v0[1]); w.y = cvt_pk_bf16(v0[2], v0[3]); w.z = cvt_pk_bf16(v1[0], v1[1]); w.w = cvt_pk_bf16(v1[2], v1[3]);
                        *(u32x4*)(rowp + bj * 32) = w; }
                } else {
                    bf16_t* vt = O + 2 * split_stride + ((size_t)((row >> 12) * 16 + head) * 64 + 8 * fq) * 4096 + (row & 4095);
#pragma unroll
                    for (int bj = 0; bj < 2; ++bj)
#pragma unroll
                        for (int n = 0; n < 2; ++n) { const f32x4 v = xv[bj][n]; const unsigned w0 = cvt_pk_bf16(v[0], v[1]), w1 = cvt_pk_bf16(v[2], v[3]);
                            bf16_t* p = vt + (size_t)(32 * bj + 4 * n) * 4096;
                            p[0] = (bf16_t)(w0 & 0xffffu); p[4096] = (bf16_t)(w0 >> 16); p[2 * 4096] = (bf16_t)(w1 & 0xffffu); p[3 * 4096] = (bf16_t)(w1 >> 16); }
                }
            }
    }
};
template <bool BASE_BF16, bool OUT_BF16> struct EpiResGate {
    static constexpr bool PERM = false, AFTER_DRAIN = false;
    const void* base; void* out; const float* gate; int gstride;
    bf16_t* hout; const float* ng; const float* nscale; float* ssq;
    typedef unsigned u32x2e __attribute__((ext_vector_type(2)));
    __device__ __forceinline__ void operator()(const f32x4 (&acc)[2][2][4][2], const Unit& u, int wr, int wc, int fr, int fq) const {
        const int b = u.pm >> 4;
        const int col0 = u.pn * BM + wc * 32 + 4 * fq;
        f32x4 gv[2][2], gm[2][2];
#pragma unroll
        for (int bj = 0; bj < 2; ++bj)
#pragma unroll
            for (int n = 0; n < 2; ++n) { gv[bj][n] = *(const f32x4*)(gate + (size_t)b * gstride + col0 + bj * HALF + n * 16);
                gm[bj][n] = hout ? *(const f32x4*)(ng + col0 + bj * HALF + n * 16) * (*(const f32x4*)(nscale + (size_t)b * gstride + col0 + bj * HALF + n * 16) + 1.0f) : (f32x4){0.f, 0.f, 0.f, 0.f}; }
        constexpr int NB = BASE_BF16 ? 4 : 2;
#pragma unroll
        for (int am = 0; am < 8 / NB; ++am) { const int ai = (am * NB) >> 2, m0 = (am * NB) & 3;
            f32x4 bs[NB][2][2];
#pragma unroll
            for (int mm = 0; mm < NB; ++mm) { const size_t off = (size_t)(u.pm * BM + ai * HALF + wr * 64 + (m0 + mm) * 16 + fr) * 1024 + col0;
#pragma unroll
                for (int bj = 0; bj < 2; ++bj)
#pragma unroll
                    for (int n = 0; n < 2; ++n) {
                        if (BASE_BF16) { const u32x2e r = *(const u32x2e*)((const bf16_t*)base + off + bj * HALF + n * 16);
                            bs[mm][bj][n] = (f32x4){__uint_as_float(r.x << 16), __uint_as_float(r.x & 0xffff0000u), __uint_as_float(r.y << 16), __uint_as_float(r.y & 0xffff0000u)}; }
                        else bs[mm][bj][n] = *(const f32x4*)((const float*)base + off + bj * HALF + n * 16); } }
#pragma unroll
            for (int mm = 0; mm < NB; ++mm) { const int m = m0 + mm; const int row = u.pm * BM + ai * HALF + wr * 64 + m * 16 + fr; const size_t off = (size_t)row * 1024 + col0;
                float ss = 0.f;
#pragma unroll
                for (int bj = 0; bj < 2; ++bj)
#pragma unroll
                    for (int n = 0; n < 2; ++n) {
                        const f32x4 xn = bs[mm][bj][n] + gv[bj][n] * acc[ai][bj][m][n];
                        if (OUT_BF16) *(u32x2e*)((bf16_t*)out + off + bj * HALF + n * 16) = (u32x2e){cvt_pk_bf16(xn[0], xn[1]), cvt_pk_bf16(xn[2], xn[3])};
                        else *(f32x4*)((float*)out + off + bj * HALF + n * 16) = xn;
                        if (hout) { ss += (xn[0] * xn[0] + xn[1] * xn[1]) + (xn[2] * xn[2] + xn[3] * xn[3]); const f32x4 a = xn * gm[bj][n];
                            *(u32x2e*)(hout + off + bj * HALF + n * 16) = (u32x2e){cvt_pk_bf16(a[0], a[1]), cvt_pk_bf16(a[2], a[3])}; } }
                if (hout) { ss += __shfl_xor(ss, 16); ss += __shfl_xor(ss, 32); if (fq == 0) __hip_atomic_fetch_add(ssq + row, ss, __ATOMIC_RELAXED, __HIP_MEMORY_SCOPE_AGENT); } }
        }
    }
};
template <class Epi, class Sched, bool ALIGN_EPI = false, bool SP2 = false>
__device__ __forceinline__ void gemm_phase(PG8_LAS unsigned char* lds, const Gemm g, const Sched& S, const Epi& E) {
    const int tid = threadIdx.x, wid = __builtin_amdgcn_readfirstlane(tid >> 6), lane = tid & 63, wr = wid >> 2, wc = wid & 3, fr = lane & 15, fq = lane >> 4;
    const int K = g.K, nt = K / BK;
    unsigned voffA[2], voffB[2];
#pragma unroll
    for (int i = 0; i < 2; ++i) { int R, C; stage_rc(tid * 16 + i * 8192, R, C); const int Rb = Epi::PERM ? ((R & ~31) + perm32(R & 31)) : R;
        voffA[i] = (unsigned)(R * K + C) * 2u; voffB[i] = (unsigned)(Rb * K + C) * 2u; }
    const size_t kstep = (size_t)(BK * 2);
    const size_t hstep = (size_t)HALF * K * 2;
    const size_t tstep = 2 * hstep;
    const unsigned ldsw = (unsigned)wid * 1024u;
    const int aoff = lds_byte(wr * 64 + fr, fq * 8), boff = lds_byte(wc * 32 + fr, fq * 8);
#define PG8_SA(b, h) (((b) * 2 + (h)) * HTB)
#define PG8_SB(b, h) ((4 + (b) * 2 + (h)) * HTB)
#define PG8_STAGE(bufoff, gbase, voff) do { _Pragma("unroll") for (int _i = 0; _i < 2; ++_i) \
        __builtin_amdgcn_global_load_lds((const unsigned*)((const char*)(gbase) + (voff)[_i]), (PG8_LAS unsigned*)(lds + (bufoff) + ldsw + _i * 8192), 16, 0, 0); } while (0)
#define PG8_LDA(dst, b, h) do { _Pragma("unroll") for (int m = 0; m < 4; ++m) _Pragma("unroll") for (int k = 0; k < 2; ++k) dst[m][k] = *(const PG8_LAS bf16x8*)(lds + PG8_SA(b, h) + aoff + m * 2048 + k * 1024); } while (0)
#define PG8_LDB(dst, b, h) do { _Pragma("unroll") for (int n = 0; n < 2; ++n) _Pragma("unroll") for (int k = 0; k < 2; ++k) dst[n][k] = *(const PG8_LAS bf16x8*)(lds + PG8_SB(b, h) + boff + n * 2048 + k * 1024); } while (0)
#define PG8_MMA(ai, bj, At, Bt) do { __builtin_amdgcn_s_setprio(1); _Pragma("unroll") for (int m = 0; m < 4; ++m) _Pragma("unroll") for (int n = 0; n < 2; ++n) _Pragma("unroll") for (int k = 0; k < 2; ++k) \
        acc[ai][bj][m][n] = __builtin_amdgcn_mfma_f32_16x16x32_bf16(Bt[n][k], At[m][k], acc[ai][bj][m][n], 0, 0, 0); __builtin_amdgcn_s_setprio(0); } while (0)
#define PG8_WAIT_V(n) asm volatile("s_waitcnt vmcnt(" #n ")" ::: "memory")
#define PG8_WAIT_L(n) asm volatile("s_waitcnt lgkmcnt(" #n ")" ::: "memory")
#define PG8_BAR __builtin_amdgcn_s_barrier()
#define PG8_SCHED __builtin_amdgcn_sched_barrier(0)
    Unit cur, nxt; int ui = 0;
    if (!S.next(0, cur)) return;
    f32x4 acc[2][2][4][2];
#pragma unroll
    for (int a = 0; a < 2; ++a)
#pragma unroll
        for (int b = 0; b < 2; ++b)
#pragma unroll
            for (int m = 0; m < 4; ++m)
#pragma unroll
                for (int n = 0; n < 2; ++n) acc[a][b][m][n] = (f32x4){0.f, 0.f, 0.f, 0.f};
    bf16x8 At[4][2], B0[2][2], B1[2][2];
    const char* cA = (const char*)g.A + (size_t)cur.pm * tstep; const char* cB = (const char*)g.Bt + (size_t)cur.pn * tstep;
    S.a_ready(cur);
    if constexpr (SP2) {
        PG8_STAGE(PG8_SB(0, 0), cB, voffB); PG8_STAGE(PG8_SB(0, 1), cB + hstep, voffB); PG8_STAGE(PG8_SA(0, 0), cA, voffA); PG8_STAGE(PG8_SA(0, 1), cA + hstep, voffA);
        if (wr == 1) PG8_BAR;
        PG8_WAIT_V(2); PG8_BAR;
        PG8_STAGE(PG8_SB(1, 0), cB + kstep, voffB); PG8_STAGE(PG8_SA(1, 0), cA + kstep, voffA); PG8_STAGE(PG8_SB(1, 1), cB + hstep + kstep, voffB);
        PG8_WAIT_V(6); PG8_BAR;
    } else {
        PG8_STAGE(PG8_SB(0, 0), cB, voffB); PG8_STAGE(PG8_SA(0, 0), cA, voffA); PG8_STAGE(PG8_SB(0, 1), cB + hstep, voffB); PG8_STAGE(PG8_SA(0, 1), cA + hstep, voffA);
        if (wr == 1) PG8_BAR;
        PG8_WAIT_V(4); PG8_BAR;
        PG8_STAGE(PG8_SB(1, 0), cB + kstep, voffB); PG8_STAGE(PG8_SA(1, 0), cA + kstep, voffA); PG8_STAGE(PG8_SB(1, 1), cB + hstep + kstep, voffB);
        PG8_WAIT_V(6); PG8_BAR;
    }
    for (;;) {
        const bool has_next = S.next(ui + 1, nxt);
        const char* nA = has_next ? (const char*)g.A + (size_t)nxt.pm * tstep : cA; const char* nB = has_next ? (const char*)g.Bt + (size_t)nxt.pn * tstep : cB;
        for (int t = 0; t < nt; t += 2) {
            const bool last = (t == nt - 2);
            const char* a1 = cA + (size_t)(t + 1) * kstep;
            const char* a2 = last ? nA : cA + (size_t)(t + 2) * kstep; const char* b2 = last ? nB : cB + (size_t)(t + 2) * kstep;
            const char* a3 = a2 + kstep; const char* b3 = b2 + kstep;
            if (last && has_next) S.a_ready(nxt);
            if constexpr (SP2) {
            PG8_LDB(B0, 0, 0); PG8_LDB(B1, 0, 1); PG8_SCHED; PG8_LDA(At, 0, 0); PG8_STAGE(PG8_SA(1, 1), a1 + hstep, voffA);
            PG8_WAIT_V(8); PG8_WAIT_L(0); PG8_BAR; PG8_MMA(0, 0, At, B0); PG8_MMA(0, 1, At, B1); PG8_BAR; PG8_SCHED;
            PG8_LDA(At, 0, 1); PG8_STAGE(PG8_SB(0, 0), b2, voffB); PG8_STAGE(PG8_SB(0, 1), b2 + hstep, voffB); PG8_STAGE(PG8_SA(0, 0), a2, voffA);
            PG8_WAIT_V(8); PG8_WAIT_L(0); PG8_BAR; PG8_MMA(1, 0, At, B0); PG8_MMA(1, 1, At, B1); PG8_BAR; PG8_SCHED;
            PG8_LDB(B0, 1, 0); PG8_LDB(B1, 1, 1); PG8_SCHED; PG8_LDA(At, 1, 0); PG8_STAGE(PG8_SA(0, 1), a2 + hstep, voffA);
            PG8_WAIT_V(8); PG8_WAIT_L(0); PG8_BAR; PG8_MMA(0, 0, At, B0); PG8_MMA(0, 1, At, B1); PG8_BAR; PG8_SCHED;
            PG8_LDA(At, 1, 1); PG8_STAGE(PG8_SB(1, 0), b3, voffB); PG8_STAGE(PG8_SB(1, 1), b3 + hstep, voffB); PG8_STAGE(PG8_SA(1, 0), a3, voffA);
            PG8_WAIT_V(8); PG8_WAIT_L(0); PG8_BAR; PG8_MMA(1, 0, At, B0); PG8_MMA(1, 1, At, B1); PG8_BAR; PG8_SCHED;
            } else {
            PG8_LDB(B0, 0, 0); PG8_SCHED; PG8_LDA(At, 0, 0); PG8_STAGE(PG8_SA(1, 1), a1 + hstep, voffA);
            PG8_WAIT_L(8); PG8_BAR; PG8_WAIT_L(0); PG8_MMA(0, 0, At, B0); PG8_BAR; PG8_SCHED;
            PG8_LDB(B1, 0, 1); PG8_STAGE(PG8_SB(0, 0), b2, voffB);
            PG8_BAR; PG8_WAIT_L(0); PG8_MMA(0, 1, At, B1); PG8_BAR;
            PG8_LDA(At, 0, 1); PG8_STAGE(PG8_SA(0, 0), a2, voffA);
            PG8_BAR; PG8_WAIT_L(0); PG8_MMA(1, 0, At, B0); PG8_BAR; PG8_SCHED;
            PG8_STAGE(PG8_SB(0, 1), b2 + hstep, voffB);
            PG8_WAIT_V(6); PG8_BAR; PG8_MMA(1, 1, At, B1); PG8_BAR;
            PG8_LDB(B0, 1, 0); PG8_SCHED; PG8_LDA(At, 1, 0); PG8_STAGE(PG8_SA(0, 1), a2 + hstep, voffA);
            PG8_WAIT_L(8); PG8_BAR; PG8_WAIT_L(0); PG8_MMA(0, 0, At, B0); PG8_BAR; PG8_SCHED;
            PG8_LDB(B1, 1, 1); PG8_STAGE(PG8_SB(1, 0), b3, voffB);
            PG8_BAR; PG8_WAIT_L(0); PG8_MMA(0, 1, At, B1); PG8_BAR;
            PG8_LDA(At, 1, 1); PG8_STAGE(PG8_SA(1, 0), a3, voffA);
            PG8_BAR; PG8_WAIT_L(0); PG8_MMA(1, 0, At, B0); PG8_BAR; PG8_SCHED;
            PG8_STAGE(PG8_SB(1, 1), b3 + hstep, voffB);
            PG8_WAIT_V(6); PG8_BAR; PG8_MMA(1, 1, At, B1); PG8_BAR;
            }
        }
        if constexpr (ALIGN_EPI) { if (wr == 0) PG8_BAR; }
        if constexpr (!Epi::AFTER_DRAIN) { E(acc, cur, wr, wc, fr, fq); S.done(cur); }
        if (!has_next) break;
#pragma unroll
        for (int a = 0; a < 2; ++a)
#pragma unroll
            for (int b = 0; b < 2; ++b)
#pragma unroll
                for (int m = 0; m < 4; ++m)
#pragma unroll
                    for (int n = 0; n < 2; ++n) acc[a][b][m][n] = (f32x4){0.f, 0.f, 0.f, 0.f};
        cur = nxt; cA = nA; cB = nB; ++ui;
        if constexpr (ALIGN_EPI) { if (wr == 1) PG8_BAR; }
    }
    PG8_WAIT_V(0);
    if constexpr (!ALIGN_EPI) { if (wr == 0) PG8_BAR; }
    PG8_BAR;
    if constexpr (Epi::AFTER_DRAIN) { E.fused(acc, cur, wr, wc, fr, fq, lds, wid, lane); S.done(cur); }
#undef PG8_SA
#undef PG8_SB
#undef PG8_STAGE
#undef PG8_LDA
#undef PG8_LDB
#undef PG8_MMA
#undef PG8_WAIT_V
#undef PG8_WAIT_L
#undef PG8_BAR
#undef PG8_SCHED
}
}

#ifndef MK_N_LAUNCHES
#define MK_N_LAUNCHES 1
#endif
#define LAS __attribute__((address_space(3)))
typedef unsigned short bf16;
typedef short bf16x8 __attribute__((ext_vector_type(8)));
typedef short s16x4 __attribute__((ext_vector_type(4)));
typedef float f32x4 __attribute__((ext_vector_type(4)));
typedef float f32x16 __attribute__((ext_vector_type(16)));
typedef unsigned u32x4 __attribute__((ext_vector_type(4)));
typedef unsigned u32x2 __attribute__((ext_vector_type(2)));
typedef float f32x2_t __attribute__((ext_vector_type(2)));
typedef __bf16 bf16x2_t __attribute__((ext_vector_type(2)));
#define MFMA32(a, b, c) __builtin_amdgcn_mfma_f32_32x32x16_bf16((a), (b), (c), 0, 0, 0)

constexpr int NWAVES = 8, NTHR = 512;
constexpr int BATCH = 8, SEQ = 4096, D = 1024, M = BATCH * SEQ, FF = 4096, AB_IN = 3584, NQKV = 3072;
constexpr int NHU = 2048;
constexpr float EPS = 1e-6f;
constexpr size_t MiB = 1u << 20;
constexpr size_t WS_MOD = 1 * MiB;
constexpr size_t WS_WIN = 2 * MiB, WS_WOUT = 9 * MiB, WS_W1_0 = 11 * MiB, WS_W2_0 = 19 * MiB, WS_WQKV = 27 * MiB, WS_WOC = 33 * MiB, WS_W1_1 = 35 * MiB, WS_W2_1 = 43 * MiB;
constexpr size_t WS_HBUF = 52 * MiB;
constexpr size_t WS_YCAT = 116 * MiB;
constexpr size_t WS_BIG = 180 * MiB;
constexpr size_t WS_INTRA = 404 * MiB;
constexpr size_t WS_XRES = 436 * MiB;
constexpr size_t WS_QE = 468 * MiB;
constexpr size_t WS_DLAST = 500 * MiB;
constexpr size_t WS_SSQ = 501 * MiB;
constexpr size_t WS_SW = 503 * MiB;
constexpr size_t WS_END = 504 * MiB;
constexpr size_t WS_CTL = 0, CTL_ZERO_BYTES = 64 * 1024;
constexpr int LDS_BYTES = 147456 + 64;
constexpr int LDS_MISC_OFF = 147456;

__device__ __forceinline__ float bf2f(bf16 v) { return __uint_as_float((unsigned)v << 16); }
__device__ __forceinline__ unsigned cvtpk(float lo, float hi) { f32x2_t v = {lo, hi}; bf16x2_t b = __builtin_convertvector(v, bf16x2_t); return __builtin_bit_cast(unsigned, b); }
__device__ __forceinline__ bf16 f2bf(float f) { return (bf16)(cvtpk(f, 0.f) & 0xffffu); }
template <int S> __device__ __forceinline__ bf16x8 pack8(const f32x16& x) {
    u32x4 p; p[0] = cvtpk(x[8 * S], x[8 * S + 1]); p[1] = cvtpk(x[8 * S + 2], x[8 * S + 3]); p[2] = cvtpk(x[8 * S + 4], x[8 * S + 5]); p[3] = cvtpk(x[8 * S + 6], x[8 * S + 7]);
    return __builtin_bit_cast(bf16x8, p);
}
__device__ __forceinline__ int crow(int r, int hi) { return (r & 3) + 8 * (r >> 2) + 4 * hi; }
__device__ __forceinline__ float wave_sum(float v) {
#pragma unroll
    for (int o = 1; o < 64; o <<= 1) v += __shfl_xor(v, o);
    return v;
}
__device__ __forceinline__ f32x16 zero16() { f32x16 z;
#pragma unroll
    for (int i = 0; i < 16; ++i) z[i] = 0.f;
    return z; }

#define XB_TMO      128
#define XB_XCNT(j)  (256  + 64 * (j))
#define XB_XSUB(j)  (1280 + 64 * (j))
#define XB_XGEN(j)  (2304 + 64 * (j))
#define XB_TOP      3328
#define XB_TOPGEN   3392
#define XCD_BAR_WORDS 3456
#define XB_SPIN_CAP (1u << 18)

__device__ __forceinline__ unsigned xb_ld(unsigned* p)              { return __hip_atomic_load(p, __ATOMIC_RELAXED, __HIP_MEMORY_SCOPE_AGENT); }
__device__ __forceinline__ unsigned xb_add(unsigned* p, unsigned v) { return __hip_atomic_fetch_add(p, v, __ATOMIC_RELAXED, __HIP_MEMORY_SCOPE_AGENT); }
__device__ __forceinline__ unsigned xb_xcc_id() { return (unsigned)__builtin_amdgcn_s_getreg((3 << 11) | 20) & 0xFu; }
#define XB_SPIN(cond, bar) do { unsigned _sp = 0; while (cond) { __builtin_amdgcn_s_sleep(1); \
    if ((++_sp & 255u) == 0u) { if (xb_ld(&(bar)[XB_TMO])) break; if (_sp > XB_SPIN_CAP) { atomicAdd(&(bar)[XB_TMO], 1u); break; } } } } while (0)

struct XcdBarrier {
    unsigned* bar; unsigned x;
    volatile LAS unsigned* st;
};

__device__ __forceinline__ XcdBarrier xcd_barrier_post(unsigned* bar, volatile LAS unsigned* st) {
    XcdBarrier b; b.bar = bar; b.x = xb_xcc_id(); b.st = st;
    if (threadIdx.x == 0) (void)xb_add(&bar[XB_XCNT(b.x)], 1u);
    return b;
}
__device__ __forceinline__ void xcd_barrier_complete(unsigned* bar, unsigned x, unsigned& nloc, unsigned& nx) {
    const unsigned G = gridDim.x * gridDim.y * gridDim.z;
    unsigned sum, cnt, mine, sp = 0u;
    for (;;) {
        sum = 0u; cnt = 0u; mine = 0u;
#pragma unroll
        for (unsigned j = 0; j < 16; ++j) { const unsigned c = xb_ld(&bar[XB_XCNT(j)]); sum += c; cnt += (c > 0u) ? 1u : 0u; mine = (j == x) ? c : mine; }
        if (sum == G) break;
        __builtin_amdgcn_s_sleep(1);
        if ((++sp & 255u) == 0u) { if (xb_ld(&bar[XB_TMO])) break; if (sp > XB_SPIN_CAP) { atomicAdd(&bar[XB_TMO], 1u); break; } }
    }
    nloc = mine > 0u ? mine : 1u; nx = cnt > 0u ? cnt : 1u;
}

__device__ __forceinline__ void xcd_barrier(const XcdBarrier& b) {
    asm volatile("s_waitcnt vmcnt(0)" ::: "memory");
    __syncthreads();
    if (threadIdx.x == 0) {
        unsigned* bar = b.bar;
        __builtin_amdgcn_s_waitcnt(0);
        unsigned nloc = b.st[0], nx = b.st[1];
        if (nloc == 0u) { xcd_barrier_complete(bar, b.x, nloc, nx); b.st[0] = nloc; b.st[1] = nx; }
        const unsigned old = xb_add(&bar[XB_XSUB(b.x)], 1u);
        const unsigned gen = old / nloc;
        if (old + 1u == (gen + 1u) * nloc) {
            __builtin_amdgcn_fence(__ATOMIC_RELEASE, "agent");
            asm volatile("s_waitcnt vmcnt(0)" ::: "memory");
            const unsigned og = xb_add(&bar[XB_TOP], 1u);
            const unsigned tg = og / nx;
            if (og + 1u == (tg + 1u) * nx) xb_add(&bar[XB_TOPGEN], 1u);
            else XB_SPIN(xb_ld(&bar[XB_TOPGEN]) == tg, bar);
            __builtin_amdgcn_fence(__ATOMIC_ACQUIRE, "agent");
            xb_add(&bar[XB_XGEN(b.x)], 1u);
            asm volatile("s_waitcnt vmcnt(0)" ::: "memory");
        } else {
            XB_SPIN(xb_ld(&bar[XB_XGEN(b.x)]) == gen, bar);
            __builtin_amdgcn_fence(__ATOMIC_ACQUIRE, "agent");
            asm volatile("s_waitcnt vmcnt(0)" ::: "memory");
        }
    }
    __syncthreads();
}

__device__ __forceinline__ void transpose_item(const float* W, int K, int N, bf16* WT, LAS float* scr, int item, int lane, bool gperm) {
    const int nblk = N / 32, kb = item / nblk, nb = item % nblk, k0 = 64 * kb, n0 = 32 * nb;
    const int lg = nb & 7, p0 = gperm ? ((nb & ~7) + 4 * (lg & 1) + (lg >> 1)) * 32 : n0;
    float wv[32];
#pragma unroll
    for (int i = 0; i < 32; ++i) wv[i] = W[(size_t)(k0 + 2 * i + (lane >> 5)) * N + n0 + (lane & 31)];
#pragma unroll
    for (int i = 0; i < 32; ++i) scr[(2 * i + (lane >> 5)) * 33 + (lane & 31)] = wv[i];
    asm volatile("s_waitcnt lgkmcnt(0)" ::: "memory");
    const int c = lane & 7;
#pragma unroll
    for (int j = 0; j < 4; ++j) { const int n = (lane >> 3) + 8 * j; const LAS float* s = scr + (8 * c) * 33 + n;
        u32x4 o; o.x = cvtpk(s[0 * 33], s[1 * 33]); o.y = cvtpk(s[2 * 33], s[3 * 33]); o.z = cvtpk(s[4 * 33], s[5 * 33]); o.w = cvtpk(s[6 * 33], s[7 * 33]);
        *(u32x4*)(WT + (size_t)(p0 + n) * K + k0 + 8 * c) = o; }
    asm volatile("s_waitcnt lgkmcnt(0)" ::: "memory");
}
struct WJob { const float* W; bf16* WT; int K, N; bool gperm; };

__device__ __forceinline__ void phase_prologue(LAS unsigned char* lds, const float* const* in, unsigned char* ws) {
    const int tid = threadIdx.x, lane = tid & 63, wid = tid >> 6;
    {
        LAS float* cact = (LAS float*)lds;
        LAS float* red = (LAS float*)(lds + 32768);
        const float* cvec = in[1]; const float* ada_w = in[2]; const float* ada_b = in[3]; float* mod = (float*)(ws + WS_MOD);
        for (int i = tid; i < 8192; i += NTHR) { const float c = cvec[i]; cact[i] = c / (1.f + __expf(-c)); }
        __syncthreads();
        for (int it = blockIdx.x; it < 192; it += gridDim.x) {
            const int l = it / 96, n0 = (it % 96) * 64, col = tid & 63, kg = tid >> 6;
            float acc[8];
#pragma unroll
            for (int b = 0; b < 8; ++b) acc[b] = 0.f;
            const float* w = ada_w + (size_t)l * 1024 * 6144 + (size_t)(kg * 128) * 6144 + n0 + col;
#pragma unroll 32
            for (int kk = 0; kk < 128; ++kk) { const float wv = w[(size_t)kk * 6144];
#pragma unroll
                for (int b = 0; b < 8; ++b) acc[b] += cact[b * 1024 + kg * 128 + kk] * wv; }
#pragma unroll
            for (int b = 0; b < 8; ++b) red[(kg * 8 + b) * 64 + col] = acc[b];
            __syncthreads();
            { const int b = tid >> 6; float s = 0.f;
#pragma unroll
              for (int g = 0; g < 8; ++g) s += red[(g * 8 + b) * 64 + col];
              mod[(size_t)(l * 8 + b) * 6144 + n0 + col] = s + ada_b[l * 6144 + n0 + col]; }
            __syncthreads();
        }
        __syncthreads();
    }
    {
        LAS float* scr = (LAS float*)(lds + wid * 16384);
        const int gw = blockIdx.x * NWAVES + wid, NGW = gridDim.x * NWAVES;
        const WJob jobs[8] = {
            {in[6], (bf16*)(ws + WS_WIN), 1024, AB_IN, false}, {in[10], (bf16*)(ws + WS_WOUT), 1024, 1024, false}, {in[11], (bf16*)(ws + WS_WQKV), 1024, NQKV, true}, {in[14], (bf16*)(ws + WS_WOC), 1024, 1024, false},
            {in[15], (bf16*)(ws + WS_W1_0), 1024, FF, false}, {in[15] + (size_t)1024 * FF, (bf16*)(ws + WS_W1_1), 1024, FF, false},
            {in[16], (bf16*)(ws + WS_W2_0), FF, 1024, false}, {in[16] + (size_t)1024 * FF, (bf16*)(ws + WS_W2_1), FF, 1024, false}};
        int base = 0;
#pragma unroll
        for (int j = 0; j < 8; ++j) {
            const int ni = (jobs[j].K / 64) * (jobs[j].N / 32);
            int first = (gw - base % NGW + NGW) % NGW;
            for (int i = first; i < ni; i += NGW) transpose_item(jobs[j].W, jobs[j].K, jobs[j].N, jobs[j].WT, scr, i, lane, jobs[j].gperm);
            base += ni;
        }
    }
}

__device__ __forceinline__ void phase_norm(const float* x, const float* g, const float* shift, const float* scale, bf16* hout) {
    const int tid = threadIdx.x, lane = tid & 63, wid = tid >> 6;
    const int gw = blockIdx.x * NWAVES + wid, NGW = gridDim.x * NWAVES;
    for (int r0 = gw * 16; r0 < M; r0 += NGW * 16) {
        const int b = r0 / SEQ;
        f32x4 gm[4], sh[4];
#pragma unroll
        for (int j = 0; j < 4; ++j) { const int col = 4 * lane + 256 * j; const f32x4 gg = *(const f32x4*)(g + col), sc = *(const f32x4*)(scale + (size_t)b * 6144 + col);
            gm[j] = gg * (sc + 1.0f); sh[j] = *(const f32x4*)(shift + (size_t)b * 6144 + col); }
#pragma unroll 4
        for (int r = 0; r < 16; ++r) {
            const size_t row = (size_t)(r0 + r);
            f32x4 v[4]; float ss = 0.f;
#pragma unroll
            for (int j = 0; j < 4; ++j) { v[j] = *(const f32x4*)(x + row * D + 4 * lane + 256 * j); ss += (v[j].x * v[j].x + v[j].y * v[j].y) + (v[j].z * v[j].z + v[j].w * v[j].w); }
            const float rstd = rsqrtf(wave_sum(ss) * (1.f / D) + EPS);
#pragma unroll
            for (int j = 0; j < 4; ++j) { const f32x4 o = v[j] * rstd * gm[j] + sh[j]; u32x2 w; w.x = cvtpk(o.x, o.y); w.y = cvtpk(o.z, o.w);
                *(u32x2*)(hout + row * D + 4 * lane + 256 * j) = w; }
        }
    }
}

__device__ __forceinline__ void phase_shiftw(const bf16* __restrict__ Wt, int N, const float* __restrict__ shift  , float* __restrict__ sW  ) {
    const int tid = threadIdx.x, lane = tid & 63, wid = tid >> 6;
    const int gw = blockIdx.x * NWAVES + wid, NGW = gridDim.x * NWAVES;
    for (int n = gw; n < N; n += NGW) {
        const bf16x8 w0 = *(const bf16x8*)(Wt + (size_t)n * 1024 + 16 * lane), w1 = *(const bf16x8*)(Wt + (size_t)n * 1024 + 16 * lane + 8);
        float wf[16];
#pragma unroll
        for (int j = 0; j < 8; ++j) { wf[j] = bf2f((bf16)w0[j]); wf[8 + j] = bf2f((bf16)w1[j]); }
#pragma unroll
        for (int b = 0; b < 8; ++b) { const f32x4* sp = (const f32x4*)(shift + (size_t)b * 6144 + 16 * lane); float s = 0.f;
#pragma unroll
            for (int q = 0; q < 4; ++q) { const f32x4 sv = sp[q]; s += (sv[0] * wf[4 * q] + sv[1] * wf[4 * q + 1]) + (sv[2] * wf[4 * q + 2] + sv[3] * wf[4 * q + 3]); }
            s = wave_sum(s);
            if (lane == 0) sW[(size_t)b * N + n] = s; }
    }
}

#define LDS_BARRIER() do { asm volatile("s_waitcnt lgkmcnt(0)" ::: "memory"); __builtin_amdgcn_s_barrier(); asm volatile("" ::: "memory"); } while (0)

__device__ __forceinline__ void phase_conv(const bf16* u, const float* conv_w, bf16* ycat) {
    const int tid = threadIdx.x, cgp = tid & 63, rg = tid >> 6;
    float w0[8], w1[8], w2[8];
#pragma unroll
    for (int j = 0; j < 8; ++j) { w0[j] = conv_w[8 * cgp + j]; w1[j] = conv_w[512 + 8 * cgp + j]; w2[j] = conv_w[1024 + 8 * cgp + j]; }
    for (int item = blockIdx.x; item < M / 32; item += gridDim.x) {
        const size_t r0 = (size_t)item * 32 + 4 * rg;
        const bool hasprev = ((int)(r0 & (SEQ - 1))) >= 2;
        const bf16* base = u + r0 * AB_IN + 8 * cgp;
        bf16x8 ac[6], ah[6], ab[4];
#pragma unroll
        for (int i = 0; i < 6; ++i) { if (i >= 2 || hasprev) { ac[i] = *(const bf16x8*)(base + (ptrdiff_t)(i - 2) * AB_IN + 512); ah[i] = *(const bf16x8*)(base + (ptrdiff_t)(i - 2) * AB_IN + 1024); }
            else { ac[i] = (bf16x8){0, 0, 0, 0, 0, 0, 0, 0}; ah[i] = ac[i]; } }
#pragma unroll
        for (int i = 0; i < 4; ++i) ab[i] = *(const bf16x8*)(base + (size_t)i * AB_IN);
        float pm2[8], pm1[8];
#pragma unroll
        for (int j = 0; j < 8; ++j) { pm2[j] = bf2f((bf16)ac[0][j]) * bf2f((bf16)ah[0][j]); pm1[j] = bf2f((bf16)ac[1][j]) * bf2f((bf16)ah[1][j]); }
#pragma unroll
        for (int i = 0; i < 4; ++i) { float y[8];
#pragma unroll
            for (int j = 0; j < 8; ++j) { const float p = bf2f((bf16)ac[i + 2][j]) * bf2f((bf16)ah[i + 2][j]); y[j] = bf2f((bf16)ab[i][j]) * (w0[j] * pm2[j] + w1[j] * pm1[j] + w2[j] * p); pm2[j] = pm1[j]; pm1[j] = p; }
            *(u32x4*)(ycat + (r0 + i) * D + 8 * cgp) = (u32x4){cvtpk(y[0], y[1]), cvtpk(y[2], y[3]), cvtpk(y[4], y[5]), cvtpk(y[6], y[7])}; }
    }
}

__device__ __forceinline__ void phase_hgrn_a(LAS unsigned char* lds, const bf16* u, const float* lb_logits,
                                             bf16* Ubuf, bf16* qeb, float* dlast, bf16* intra) {
    const int tid = threadIdx.x, lane = tid & 63, wid = tid >> 6, r32 = lane & 31, hi = lane >> 5;
    LAS bf16* qm = (LAS bf16*)(lds);
    LAS bf16* km = (LAS bf16*)(lds + 17408);
    LAS bf16* klT = (LAS bf16*)(lds + 34816);
    LAS bf16* vT = (LAS bf16*)(lds + 34816 + 18432);
    LAS float* part = (LAS float*)(lds + 71680);
    LAS bf16* hfR = (LAS bf16*)(lds + 73728);
    LAS bf16* qR = (LAS bf16*)(lds + 73728 + 17408);
    LAS bf16* vR = (LAS bf16*)(lds + 73728 + 34816);
    LAS bf16* hfR2 = (LAS bf16*)(lds + 73728 + 52224);
    const int ch = tid & 127, tq = tid >> 7;
    const int srow = tid >> 4, sseg = tid & 15;
    u32x4 R[6];
#define HG_LOAD(unit_) do { const int bh_ = (unit_) >> 6, c_ = (unit_) & 63; const bf16* p_ = u + ((size_t)(bh_ >> 2) * SEQ + (size_t)c_ * 64 + srow) * AB_IN + (bh_ & 3) * 128 + 8 * sseg; \
        R[0] = *(const u32x4*)(p_ + 2048); R[1] = *(const u32x4*)(p_ + 2048 + (size_t)32 * AB_IN); R[2] = *(const u32x4*)(p_ + 1536); R[3] = *(const u32x4*)(p_ + 1536 + (size_t)32 * AB_IN); \
        R[4] = *(const u32x4*)(p_ + 2560); R[5] = *(const u32x4*)(p_ + 2560 + (size_t)32 * AB_IN); } while (0)
    if ((int)blockIdx.x < NHU) HG_LOAD(blockIdx.x);
    float lbh[4];
#pragma unroll
    for (int hh = 0; hh < 4; ++hh) { const int f = hh * 128 + ch; const float l0 = lb_logits[f], l1 = lb_logits[512 + f], l2 = lb_logits[1024 + f]; const float mx = fmaxf(l0, fmaxf(l1, l2));
        const float e0 = __expf(l0 - mx), e1 = __expf(l1 - mx), e2 = __expf(l2 - mx); lbh[hh] = e0 / (e0 + e1 + e2); }
#define HG_PARK_HF(HB) do { *(LAS u32x4*)((HB) + srow * 136 + 8 * sseg) = R[0]; *(LAS u32x4*)((HB) + (srow + 32) * 136 + 8 * sseg) = R[1]; } while (0)
#define HG_PARK_QV() do { *(LAS u32x4*)(qR + srow * 136 + 8 * sseg) = R[2]; *(LAS u32x4*)(qR + (srow + 32) * 136 + 8 * sseg) = R[3]; \
        *(LAS u32x4*)(vR + srow * 136 + 8 * sseg) = R[4]; *(LAS u32x4*)(vR + (srow + 32) * 136 + 8 * sseg) = R[5]; } while (0)
#define HG_S1(unit_, HB) do { const int h_ = ((unit_) >> 6) & 3; const float lb_ = h_ == 0 ? lbh[0] : h_ == 1 ? lbh[1] : h_ == 2 ? lbh[2] : lbh[3]; const float oml_ = 1.f - lb_; float run_ = 0.f; \
        _Pragma("unroll") for (int i = 0; i < 16; ++i) { float hf = bf2f((HB)[(16 * tq + i) * 136 + ch]); hf = fminf(fmaxf(hf, -40.f), 40.f); \
            const float e = __expf(-hf), sig = __builtin_amdgcn_rcpf(1.f + e); lf[i] = __logf(lb_ + oml_ * sig); kv[i] = oml_ * e * sig; run_ += lf[i]; } \
        part[tq * 128 + ch] = run_; } while (0)
    float lf[16], kv[16];
    if ((int)blockIdx.x < NHU) { HG_PARK_HF(hfR); HG_PARK_QV(); if ((int)blockIdx.x + (int)gridDim.x < NHU) HG_LOAD(blockIdx.x + gridDim.x); LDS_BARRIER(); HG_S1((int)blockIdx.x, hfR); LDS_BARRIER(); }
    LAS bf16* hfn = hfR2;
    for (int unit = blockIdx.x; unit < NHU; unit += gridDim.x) {
        const bool has_next = unit + (int)gridDim.x < NHU;
        if (has_next) HG_PARK_HF(hfn);
        const float p0 = part[ch], p1 = part[128 + ch], p2 = part[256 + ch], p3 = part[384 + ch];
        const float off = (tq > 0 ? p0 : 0.f) + (tq > 1 ? p1 : 0.f) + (tq > 2 ? p2 : 0.f), bmid = p0 + p1, blast = (p0 + p1) + (p2 + p3);
        if (tq == 0) dlast[(size_t)unit * 128 + ch] = __expf(blast);
        {
            bf16* qep = qeb + ((size_t)unit * 64 + 16 * tq) * 128 + ch;
            float bb = off;
            const float emid = __expf(bmid), iemid = __expf(-bmid), elast = __expf(blast);
#pragma unroll
            for (int i4 = 0; i4 < 4; ++i4) {
                float klv[4]; unsigned vr[4];
#pragma unroll
                for (int e4 = 0; e4 < 4; ++e4) { const int i = 4 * i4 + e4, t = 16 * tq + i;
                    bb += lf[i]; const float q = bf2f(qR[t * 136 + ch]);
                    const float eb = __expf(bb), ieb = __builtin_amdgcn_rcpf(eb);
                    const float qe = q * eb, ki = kv[i] * ieb;
                    qep[(size_t)i * 128] = f2bf(qe);
                    qm[t * 136 + ch] = f2bf(qe * iemid);
                    km[t * 136 + ch] = f2bf(ki * emid);
                    klv[e4] = ki * elast;
                    vr[e4] = vR[t * 136 + ch]; }
                *(LAS u32x2*)(klT + ch * 72 + 16 * tq + 4 * i4) = (u32x2){cvtpk(klv[0], klv[1]), cvtpk(klv[2], klv[3])};
                *(LAS u32x2*)(vT + ch * 72 + 16 * tq + 4 * i4) = (u32x2){vr[0] | (vr[1] << 16), vr[2] | (vr[3] << 16)};
            }
        }
        LDS_BARRIER();
        if (has_next) { HG_PARK_QV(); if (unit + 2 * (int)gridDim.x < NHU) HG_LOAD(unit + 2 * gridDim.x); }
        HG_S1(has_next ? unit + (int)gridDim.x : unit, hfn);
        hfn = (hfn == hfR2) ? hfR : hfR2;
        {
            const int tblk = wid & 1, vblk = wid >> 1;
            f32x16 acc = zero16();
#pragma unroll
            for (int sblk = 0; sblk < 2; ++sblk) if (sblk <= tblk) {
                f32x16 sT = zero16();
#pragma unroll
                for (int k8 = 0; k8 < 8; ++k8) { const bf16x8 a = *(const LAS bf16x8*)(km + (32 * sblk + r32) * 136 + 16 * k8 + 8 * hi);
                    const bf16x8 bq = *(const LAS bf16x8*)(qm + (32 * tblk + r32) * 136 + 16 * k8 + 8 * hi); sT = MFMA32(a, bq, sT); }
                if (sblk == tblk) {
#pragma unroll
                    for (int r = 0; r < 16; ++r) if (crow(r, hi) > r32) sT[r] = 0.f;
                }
                { const bf16x8 xs = pack8<0>(sT); const LAS bf16* vb = vT + (32 * vblk + r32) * 72 + 32 * sblk + 4 * hi;
                  const s16x4 lo = *(const LAS s16x4*)(vb), h4 = *(const LAS s16x4*)(vb + 8); const bf16x8 pb = __builtin_shufflevector(lo, h4, 0, 1, 2, 3, 4, 5, 6, 7); acc = MFMA32(xs, pb, acc); }
                { const bf16x8 xs = pack8<1>(sT); const LAS bf16* vb = vT + (32 * vblk + r32) * 72 + 32 * sblk + 16 + 4 * hi;
                  const s16x4 lo = *(const LAS s16x4*)(vb), h4 = *(const LAS s16x4*)(vb + 8); const bf16x8 pb = __builtin_shufflevector(lo, h4, 0, 1, 2, 3, 4, 5, 6, 7); acc = MFMA32(xs, pb, acc); }
            }
#pragma unroll
            for (int r = 0; r < 16; ++r) intra[((size_t)unit * 64 + 32 * tblk + crow(r, hi)) * 128 + 32 * vblk + r32] = f2bf(acc[r]);
#pragma unroll
            for (int kb2 = 0; kb2 < 2; ++kb2) { const int kblk = 2 * (wid & 1) + kb2, vb = wid >> 1;
                f32x16 ua = zero16();
#pragma unroll
                for (int i = 0; i < 4; ++i) { const bf16x8 a = *(const LAS bf16x8*)(vT + (32 * vb + r32) * 72 + 16 * i + 8 * hi);
                    const bf16x8 bb = *(const LAS bf16x8*)(klT + (32 * kblk + r32) * 72 + 16 * i + 8 * hi); ua = MFMA32(a, bb, ua); }
#pragma unroll
                for (int r = 0; r < 16; ++r) Ubuf[(size_t)unit * 16384 + (size_t)(32 * vb + crow(r, hi)) * 128 + 32 * kblk + r32] = f2bf(ua[r]);
            }
        }
        LDS_BARRIER();
    }
#undef HG_LOAD
#undef HG_PARK_HF
#undef HG_PARK_QV
#undef HG_S1
}

__device__ __forceinline__ void phase_hgrn_scan(const bf16* __restrict__ Ubuf, const float* __restrict__ dlast, bf16* __restrict__ Sprev) {
    for (int gid = blockIdx.x * NTHR + threadIdx.x; gid < 32 * 4096; gid += gridDim.x * NTHR) {
        const int bh = gid >> 12, rem = gid & 4095, v = rem >> 5, k4 = (rem & 31) * 4;
        f32x4 S = (f32x4){0.f, 0.f, 0.f, 0.f};
#pragma unroll 16
        for (int c = 0; c < 64; ++c) { const size_t unit = (size_t)bh * 64 + c;
            const u32x2 ur = *(const u32x2*)(Ubuf + unit * 16384 + v * 128 + k4); const f32x4 d = *(const f32x4*)(dlast + unit * 128 + k4);
            const f32x4 U = (f32x4){__uint_as_float(ur.x << 16), __uint_as_float(ur.x & 0xffff0000u), __uint_as_float(ur.y << 16), __uint_as_float(ur.y & 0xffff0000u)};
            u32x2 w; w.x = cvtpk(S.x, S.y); w.y = cvtpk(S.z, S.w); *(u32x2*)(Sprev + unit * 16384 + v * 128 + k4) = w;
            S = d * S + U; }
    }
}

__device__ __forceinline__ void phase_hgrn_c(LAS unsigned char* lds, const bf16* u, const bf16* qeb, const bf16* Sprev, const bf16* intra, const float* hg_norm, bf16* ycat) {
    const int tid = threadIdx.x, lane = tid & 63, wid = tid >> 6, r32 = lane & 31, hi = lane >> 5;
    LAS float* ob = (LAS float*)lds;
    LAS bf16* qeT = (LAS bf16*)(lds + 33792);
    LAS bf16* spT = (LAS bf16*)(lds + 33792 + 17408);
    LAS bf16* inT = (LAS bf16*)(lds + 33792 + 17408 + 34816);
    const int tblk = wid & 1, vblk = wid >> 1;
    const int nt = tid >> 3, seg = tid & 7;
    const int srow = tid >> 4, sseg = tid & 15;
    u32x4 sq[2], sp[4], si[2]; bf16x8 g0, g1;
#define HC_LOAD(unit_) do { const int un_ = (unit_); const int bh_ = un_ >> 6, c_ = un_ & 63; \
        _Pragma("unroll") for (int i = 0; i < 2; ++i) { sq[i] = *(const u32x4*)(qeb + ((size_t)un_ * 64 + srow + 32 * i) * 128 + 8 * sseg); si[i] = *(const u32x4*)(intra + ((size_t)un_ * 64 + srow + 32 * i) * 128 + 8 * sseg); } \
        _Pragma("unroll") for (int i = 0; i < 4; ++i) sp[i] = *(const u32x4*)(Sprev + (size_t)un_ * 16384 + (size_t)(srow + 32 * i) * 128 + 8 * sseg); \
        const bf16* hgp_ = u + ((size_t)(bh_ >> 2) * SEQ + (size_t)c_ * 64 + nt) * AB_IN + 3072 + (bh_ & 3) * 128 + 16 * seg; \
        g0 = *(const bf16x8*)(hgp_); g1 = *(const bf16x8*)(hgp_ + 8); } while (0)
    if ((int)blockIdx.x < NHU) HC_LOAD(blockIdx.x);
    for (int unit = blockIdx.x; unit < NHU; unit += gridDim.x) {
        const int bh = unit >> 6, c = unit & 63, b = bh >> 2, h = bh & 3;
        const size_t row0 = (size_t)b * SEQ + (size_t)c * 64;
#pragma unroll
        for (int i = 0; i < 2; ++i) { *(LAS u32x4*)(qeT + (srow + 32 * i) * 136 + 8 * sseg) = sq[i]; *(LAS u32x4*)(inT + (srow + 32 * i) * 136 + 8 * sseg) = si[i]; }
#pragma unroll
        for (int i = 0; i < 4; ++i) *(LAS u32x4*)(spT + (srow + 32 * i) * 136 + 8 * sseg) = sp[i];
        const bf16x8 gc0 = g0, gc1 = g1;
        LDS_BARRIER();
        if (unit + (int)gridDim.x < NHU) HC_LOAD(unit + gridDim.x);
        f32x16 acc = zero16();
#pragma unroll
        for (int k8 = 0; k8 < 8; ++k8) acc = MFMA32(*(const LAS bf16x8*)(qeT + (32 * tblk + r32) * 136 + 16 * k8 + 8 * hi), *(const LAS bf16x8*)(spT + (32 * vblk + r32) * 136 + 16 * k8 + 8 * hi), acc);
#pragma unroll
        for (int r = 0; r < 16; ++r) { const int t = 32 * tblk + crow(r, hi), v = 32 * vblk + r32; ob[t * 132 + v] = acc[r] + bf2f(inT[t * 136 + v]); }
        LDS_BARRIER();
        { const int t = nt; float o[16]; float ss = 0.f;
#pragma unroll
          for (int i = 0; i < 16; i += 4) { const f32x4 q4 = *(const LAS f32x4*)(ob + t * 132 + 16 * seg + i); o[i] = q4.x; o[i + 1] = q4.y; o[i + 2] = q4.z; o[i + 3] = q4.w; ss += (q4.x * q4.x + q4.y * q4.y) + (q4.z * q4.z + q4.w * q4.w); }
          ss += __shfl_xor(ss, 1); ss += __shfl_xor(ss, 2); ss += __shfl_xor(ss, 4);
          const float rstd = rsqrtf(ss * (1.f / 128.f) + EPS);
          const float* gn = hg_norm + h * 128 + 16 * seg;
          unsigned w[8];
#pragma unroll
          for (int i = 0; i < 16; i += 2) { float y[2];
#pragma unroll
              for (int e2 = 0; e2 < 2; ++e2) { const int i2 = i + e2; const float hg = bf2f((bf16)(i2 < 8 ? gc0[i2 & 7] : gc1[i2 & 7])); const float sl = hg / (1.f + __expf(-hg)); y[e2] = o[i2] * rstd * gn[i2] * sl; }
              w[i >> 1] = cvtpk(y[0], y[1]); }
          bf16* yp = ycat + (row0 + t) * D + 512 + h * 128 + 16 * seg;
          *(u32x4*)(yp) = (u32x4){w[0], w[1], w[2], w[3]}; *(u32x4*)(yp + 8) = (u32x4){w[4], w[5], w[6], w[7]}; }
    }
#undef HC_LOAD
}

constexpr int AT_NSLOT = 7, AT_SLOT_ELEMS = 9216;
__device__ __forceinline__ void phase_attn(LAS unsigned char* lds, const bf16* Q, const bf16* K, const bf16* VT, bf16* O) {
    const int tid = threadIdx.x, lane = tid & 63, wid = tid >> 6, r32 = lane & 31, hi = lane >> 5;
    const int pr = (r32 & ~12) | ((r32 & 4) << 1) | ((r32 & 8) >> 1);
    LAS bf16* img = (LAS bf16*)lds;
    LAS int* flags = (LAS int*)(lds + AT_NSLOT * AT_SLOT_ELEMS * 2);
    const int srow = tid >> 3, sseg = tid & 7;
    for (int unit = blockIdx.x; unit < NHU; unit += gridDim.x) {
        const int bh = unit >> 4, qb = unit & 15, b = bh >> 4, h = bh & 15;
        const int q0 = qb * 256 + 32 * wid;
        const int mydiag = (q0 + 31) >> 6;
        const bf16* Ks = K + ((size_t)b * SEQ + srow) * D + h * 64 + 8 * sseg;
        const bf16* Vs = VT + ((size_t)bh * 64 + srow) * SEQ + 8 * sseg;
        bf16x8 qn[4];
#pragma unroll
        for (int d0 = 0; d0 < 4; ++d0) qn[d0] = *(const bf16x8*)(Q + ((size_t)b * SEQ + q0 + r32) * D + h * 64 + 16 * d0 + 8 * hi);
        float carry = 1.f; f32x16 o0 = zero16(), o1 = zero16();
        const int qpos = q0 + r32;
        bool wdone = false;
        for (int jbase = 4 * qb + 3; ; jbase -= AT_NSLOT) {
            const int nt = jbase + 1 < AT_NSLOT ? jbase + 1 : AT_NSLOT;
            {
                u32x4 kr[AT_NSLOT], vr[AT_NSLOT];
#pragma unroll
                for (int s = 0; s < AT_NSLOT; ++s) if (s < nt) { kr[s] = *(const u32x4*)(Ks + (size_t)(64 * (jbase - s)) * D); vr[s] = *(const u32x4*)(Vs + 64 * (jbase - s)); }
#pragma unroll
                for (int s = 0; s < AT_NSLOT; ++s) if (s < nt) { *(LAS u32x4*)(img + s * AT_SLOT_ELEMS + srow * 72 + 8 * sseg) = kr[s];
                    *(LAS u32x4*)(img + s * AT_SLOT_ELEMS + AT_SLOT_ELEMS / 2 + srow * 72 + 8 * sseg) = vr[s]; }
                __syncthreads();
            }
            if (!wdone) {
                const int jlo = jbase - nt + 1;
                for (int jt = (jbase < mydiag ? jbase : mydiag); jt >= jlo; --jt) {
                    const LAS bf16* Kt = img + (jbase - jt) * AT_SLOT_ELEMS; const LAS bf16* Vt = Kt + AT_SLOT_ELEMS / 2;
                    f32x16 p0 = zero16(), p1 = zero16();
#pragma unroll
                    for (int d0 = 0; d0 < 4; ++d0) { const bf16x8 a0 = *(const LAS bf16x8*)(Kt + pr * 72 + 16 * d0 + 8 * hi), a1 = *(const LAS bf16x8*)(Kt + (32 + pr) * 72 + 16 * d0 + 8 * hi);
                        p0 = MFMA32(a0, qn[d0], p0); p1 = MFMA32(a1, qn[d0], p1); }
                    const int kbase = 64 * jt + 8 * hi;
                    const bool diag = jt == mydiag;
#define VB(i, dh) (*(const LAS bf16x8*)(Vt + (32 * (dh) + r32) * 72 + 16 * (i) + 8 * hi))
#define AT_BETA(P, C, HF) do { \
                    _Pragma("unroll") for (int r = 0; r < 16; ++r) { C[r] = __builtin_amdgcn_rcpf(1.f + __builtin_amdgcn_exp2f(P[r])); P[r] = 1.f - C[r]; }     \
                    if (diag) { _Pragma("unroll") for (int r = 0; r < 16; ++r) { const int key = kbase + 32 * (HF) + 16 * (r >> 3) + (r & 7); if (key >= qpos) { C[r] = 1.f; P[r] = 0.f; } } } } while (0)
#define AT_TOT(C, T0, T1) do { T0 = ((C[0] * C[1]) * (C[2] * C[3])) * ((C[4] * C[5]) * (C[6] * C[7])); T1 = ((C[8] * C[9]) * (C[10] * C[11])) * ((C[12] * C[13]) * (C[14] * C[15])); } while (0)
                    float c1[16], c0[16], t10, t11, t00, t01;
                    AT_BETA(p1, c1, 1); AT_BETA(p0, c0, 0);
                    AT_TOT(c1, t10, t11); AT_TOT(c0, t00, t01);
                    const float u10 = __shfl_xor(t10, 32), u11 = __shfl_xor(t11, 32), u00 = __shfl_xor(t00, 32), u01 = __shfl_xor(t01, 32);
                    const float g1all1 = t11 * u11, T1 = (t10 * u10) * g1all1;
                    const float g1all0 = t01 * u01, T0 = (t00 * u00) * g1all0;
                    const float carry0 = carry * T1;
                    { float sa = (hi ? 1.f : u10) * g1all1 * carry, sb = (hi ? 1.f : u11) * carry, sc = (hi ? 1.f : u00) * g1all0 * carry0, sd = (hi ? 1.f : u01) * carry0;
                      _Pragma("unroll") for (int j = 7; j >= 0; --j) { p1[j] *= sa; sa *= c1[j]; p1[8 + j] *= sb; sb *= c1[8 + j]; p0[j] *= sc; sc *= c0[j]; p0[8 + j] *= sd; sd *= c0[8 + j]; } }
                    carry = carry0 * T0;
                    { const bf16x8 psA = pack8<0>(p1), psB = pack8<1>(p1), psC = pack8<0>(p0), psD = pack8<1>(p0);
                      o0 = MFMA32(psA, VB(2, 0), o0); o1 = MFMA32(psA, VB(2, 1), o1); o0 = MFMA32(psB, VB(3, 0), o0); o1 = MFMA32(psB, VB(3, 1), o1);
                      o0 = MFMA32(psC, VB(0, 0), o0); o1 = MFMA32(psC, VB(0, 1), o1); o0 = MFMA32(psD, VB(1, 0), o0); o1 = MFMA32(psD, VB(1, 1), o1); }
#undef AT_BETA
#undef AT_TOT
#undef VB
                    if (__all(carry == 0.f)) { wdone = true; break; }
                }
            }
            if (lane == 0) flags[wid] = wdone ? 1 : 0;
            __syncthreads();
            const int alld = flags[0] & flags[1] & flags[2] & flags[3] & flags[4] & flags[5] & flags[6] & flags[7];
            if (jbase - AT_NSLOT < 0 || alld) break;
        }
        { bf16* op = O + ((size_t)b * SEQ + q0) * D + h * 64 + r32;
#pragma unroll
          for (int r = 0; r < 16; ++r) { const int q = crow(r, hi); op[(size_t)q * D] = f2bf(o0[r]); op[(size_t)q * D + 32] = f2bf(o1[r]); } }
    }
}

struct Args { const float* in[17]; float* out; unsigned char* ws; int ph_lo, ph_hi; };
constexpr int N_PHASES = 14;

__global__ void __launch_bounds__(NTHR, 2) trunk_fwd(Args args) {
    extern __shared__ __attribute__((aligned(16))) unsigned char lds_raw[];
    LAS unsigned char* lds = (LAS unsigned char*)lds_raw;
    cg::grid_group grid = cg::this_grid();
    volatile LAS unsigned* misc = (volatile LAS unsigned*)(lds + LDS_MISC_OFF);
    if (threadIdx.x < 16) misc[threadIdx.x] = 0u;
    __syncthreads();
    XcdBarrier bar = xcd_barrier_post((unsigned*)(args.ws + WS_CTL), misc);
    unsigned char* ws = args.ws;
    const int lo = args.ph_lo, hi_ph = args.ph_hi;
#define IN(k) (lo <= (k) && (k) < hi_ph)
#ifndef USE_CG_SYNC
#define USE_CG_SYNC (args.ph_hi > 1000)
#endif
#define SEAM(k) do { if (IN(k) && IN((k) + 1)) { if (USE_CG_SYNC) grid.sync(); else xcd_barrier(bar); } } while (0)
    bf16* xres = (bf16*)(ws + WS_XRES);
    const float* mod = (const float*)(ws + WS_MOD);
    bf16* hbuf = (bf16*)(ws + WS_HBUF); bf16* ycat = (bf16*)(ws + WS_YCAT); bf16* big = (bf16*)(ws + WS_BIG);
    const int G = gridDim.x, bid = blockIdx.x;

    float* ssq_a = (float*)(ws + WS_SSQ); float* ssq_b = ssq_a + M; float* ssq_c = ssq_b + M;
    float* sw_up0 = (float*)(ws + WS_SW); float* sw_qkv = sw_up0 + 8 * FF; float* sw_up1 = sw_qkv + 8 * NQKV;
    const float* mod1 = mod + 8 * 6144;
    if (IN(0)) { phase_prologue(lds, args.in, ws); } SEAM(0);
    if (IN(1)) { phase_norm(args.in[0], args.in[4], mod + 0, mod + 1024, hbuf);
 } SEAM(1);
    if (IN(2)) { pg8::Gemm g{hbuf, (const bf16*)(ws + WS_WIN), M, AB_IN, D}; pg8::StaticOrder S; S.init(M, AB_IN, G, bid);
        pg8::EpiBf16<0> E{big, AB_IN, nullptr, 0, nullptr, EPS}; pg8::gemm_phase<pg8::EpiBf16<0>, pg8::StaticOrder, true, true>(lds, g, S, E); } SEAM(2);
    if (IN(3)) { phase_conv(big, args.in[7], ycat);
        phase_hgrn_a(lds, big, args.in[9], (bf16*)args.out  , (bf16*)(ws + WS_QE), (float*)(ws + WS_DLAST), (bf16*)(ws + WS_INTRA)); } SEAM(3);
    if (IN(4)) { phase_hgrn_scan((const bf16*)args.out, (const float*)(ws + WS_DLAST), hbuf  );
        for (int i = bid * NTHR + threadIdx.x; i < 3 * M; i += G * NTHR) ssq_a[i] = 0.f;
        phase_shiftw((const bf16*)(ws + WS_W1_0), FF, mod + 3072, sw_up0); phase_shiftw((const bf16*)(ws + WS_WQKV), NQKV, mod1 + 0, sw_qkv); phase_shiftw((const bf16*)(ws + WS_W1_1), FF, mod1 + 3072, sw_up1); } SEAM(4);
    if (IN(5)) { phase_hgrn_c(lds, big, (const bf16*)(ws + WS_QE), hbuf, (const bf16*)(ws + WS_INTRA), args.in[8], ycat); } SEAM(5);
    if (IN(6)) { pg8::Gemm g{ycat, (const bf16*)(ws + WS_WOUT), M, D, D}; pg8::StaticOrder S; S.init(M, D, G, bid);
        pg8::EpiResGate<false, true> E{args.in[0], xres, mod + 2048, 6144, hbuf, args.in[5], mod + 4096, ssq_a}; pg8::gemm_phase<pg8::EpiResGate<false, true>, pg8::StaticOrder, true, true>(lds, g, S, E); } SEAM(6);
    if (IN(7)) { pg8::Gemm g{hbuf, (const bf16*)(ws + WS_W1_0), M, FF, D}; pg8::StaticOrder S; S.init(M, FF, G, bid);
        pg8::EpiBf16<1> E{big, FF, sw_up0, FF, ssq_a, EPS}; pg8::gemm_phase<pg8::EpiBf16<1>, pg8::StaticOrder, true, true>(lds, g, S, E); } SEAM(7);
    if (IN(8)) { pg8::Gemm g{big, (const bf16*)(ws + WS_W2_0), M, D, FF}; pg8::StaticOrder S; S.init(M, D, G, bid);
        pg8::EpiResGate<true, true> E{xres, xres, mod + 5120, 6144, hbuf, args.in[4] + D, mod1 + 1024, ssq_b}; pg8::gemm_phase<pg8::EpiResGate<true, true>, pg8::StaticOrder, true, true>(lds, g, S, E); } SEAM(8);
    if (IN(9)) { pg8::Gemm g{hbuf, (const bf16*)(ws + WS_WQKV), M, NQKV, D}; pg8::StaticOrder S; S.init(M, NQKV, G, bid);
        pg8::EpiQKV E{big, (size_t)M * D, args.in[12], args.in[13], EPS, sw_qkv, NQKV, ssq_b}; pg8::gemm_phase<pg8::EpiQKV, pg8::StaticOrder, true, true>(lds, g, S, E); } SEAM(9);
    if (IN(10)) { phase_attn(lds, big, big + (size_t)M * D, big + (size_t)2 * M * D, ycat); } SEAM(10);
    if (IN(11)) { pg8::Gemm g{ycat, (const bf16*)(ws + WS_WOC), M, D, D}; pg8::StaticOrder S; S.init(M, D, G, bid);
        pg8::EpiResGate<true, true> E{xres, xres, mod1 + 2048, 6144, hbuf, args.in[5] + D, mod1 + 4096, ssq_c}; pg8::gemm_phase<pg8::EpiResGate<true, true>, pg8::StaticOrder, true, true>(lds, g, S, E); } SEAM(11);
    if (IN(12)) { pg8::Gemm g{hbuf, (const bf16*)(ws + WS_W1_1), M, FF, D}; pg8::StaticOrder S; S.init(M, FF, G, bid);
        pg8::EpiBf16<1> E{big, FF, sw_up1, FF, ssq_c, EPS}; pg8::gemm_phase<pg8::EpiBf16<1>, pg8::StaticOrder, true, true>(lds, g, S, E); } SEAM(12);
    if (IN(13)) { pg8::Gemm g{big, (const bf16*)(ws + WS_W2_1), M, D, FF}; pg8::StaticOrder S; S.init(M, D, G, bid);
        pg8::EpiResGate<true, false> E{xres, args.out, mod1 + 5120, 6144, nullptr, nullptr, nullptr, nullptr}; pg8::gemm_phase<pg8::EpiResGate<true, false>, pg8::StaticOrder, true, true>(lds, g, S, E); }
#undef IN
#undef SEAM
}

extern "C" void kernel_launch(void* const* d_in, const int* in_sizes, int n_in, void* d_out, int out_size, void* d_ws, size_t ws_size, hipStream_t stream) {
    static int grid = 0;
    if (grid == 0) {
        if (n_in != 17 || in_sizes[0] != M * D || out_size != M * D || ws_size < WS_END) {
            fprintf(stderr, "kernel_launch: unexpected shapes (n_in %d, in0 %d, out %d, ws %zu); nothing launched\n", n_in, n_in > 0 ? in_sizes[0] : -1, out_size, ws_size); grid = -1; return; }
        int dev = 0, cus = 0, per_cu = 0;
        if (hipGetDevice(&dev) != hipSuccess || hipDeviceGetAttribute(&cus, hipDeviceAttributeMultiprocessorCount, dev) != hipSuccess) { grid = -1; return; }
        if (hipFuncSetAttribute((const void*)trunk_fwd, hipFuncAttributeMaxDynamicSharedMemorySize, LDS_BYTES) != hipSuccess) { fprintf(stderr, "kernel_launch: hipFuncSetAttribute failed\n"); grid = -1; return; }
        if (hipOccupancyMaxActiveBlocksPerMultiprocessor(&per_cu, (const void*)trunk_fwd, NTHR, LDS_BYTES) != hipSuccess || per_cu < 1) { fprintf(stderr, "kernel_launch: occupancy query says %d\n", per_cu); per_cu = 1; }
        (void)hipGetLastError();
        grid = cus * per_cu;
    }
    if (grid < 0) return;
    if (hipMemsetAsync((char*)d_ws + WS_CTL, 0, CTL_ZERO_BYTES, stream) != hipSuccess) { fprintf(stderr, "kernel_launch: memset failed\n"); return; }
    Args a{};
    for (int i = 0; i < 17; ++i) a.in[i] = (const float*)d_in[i];
    a.out = (float*)d_out; a.ws = (unsigned char*)d_ws;
#if MK_N_LAUNCHES == 1
    a.ph_lo = 0; a.ph_hi = N_PHASES;
    void* kargs[] = {&a};
    hipError_t e = hipLaunchCooperativeKernel((const void*)trunk_fwd, dim3(grid), dim3(NTHR), kargs, LDS_BYTES, stream);
    if (e != hipSuccess) fprintf(stderr, "kernel_launch: cooperative launch failed: %s (grid %d)\n", hipGetErrorString(e), grid);
#else
    for (int p = 0; p < N_PHASES; ++p) { a.ph_lo = p; a.ph_hi = p + 1; hipLaunchKernelGGL(trunk_fwd, dim3(grid), dim3(NTHR), LDS_BYTES, stream, a); }
#endif
}
```

```cpp
#include <hip/hip_runtime.h>
#include <hip/hip_cooperative_groups.h>
#include <cstdio>
#include <cstdint>
namespace cg = cooperative_groups;
namespace pg8 {
#define PG8_LAS __attribute__((address_space(3)))
typedef unsigned short bf16_t;
typedef short bf16x8 __attribute__((ext_vector_type(8)));
typedef float f32x4 __attribute__((ext_vector_type(4)));
typedef unsigned u32x4 __attribute__((ext_vector_type(4)));
constexpr int BM = 256, BK = 64, HALF = 128, HTB = HALF * BK * 2  , STAGE_BYTES = 8 * HTB, NXCD = 8, WGM = 8;

__host__ __device__ __forceinline__ int lds_byte(int r, int c) { const int st = (r >> 4) * 2 + (c >> 5), rr = r & 15, cc = c & 31, ob = rr * 64 + cc * 2; return st * 1024 + (ob ^ (((ob >> 9) & 1) << 5)); }
__host__ __device__ __forceinline__ void stage_rc(int b, int& R, int& C) { const int st = b / 1024, sb = b % 1024, swz = sb ^ (((sb >> 9) & 1) << 5); R = (st >> 1) * 16 + swz / 64; C = (st & 1) * 32 + (swz % 64) / 2; }
__host__ __device__ __forceinline__ int perm32(int rho) { const int n = rho >> 4, i = rho & 15; return 8 * (i >> 2) + 4 * n + (i & 3); }

struct Unit { int pm, pn; };
struct Gemm { const bf16_t* A; const bf16_t* Bt; int M, N, K; };

struct StaticOrder {
    int nM, nN, nwg, G, c;
    __host__ __device__ void init(int M, int N, int G_, int c_) { nM = M / BM; nN = N / BM; nwg = nM * nN; G = G_; c = c_; }
    __host__ __device__ bool next(int i, Unit& u) const {
        const long L = (long)i * G + c; if (L >= nwg) return false;
        int wgid = (int)L; { const int q = nwg / NXCD, r = nwg % NXCD, xcd = wgid % NXCD, off = wgid / NXCD; wgid = (xcd < r ? xcd * (q + 1) : r * (q + 1) + (xcd - r) * q) + off; }
        const int nig = WGM * nN, gid = wgid / nig, fm = gid * WGM, gsz = (nM - fm) < WGM ? (nM - fm) : WGM;
        u.pm = fm + ((wgid % nig) % gsz); u.pn = (wgid % nig) / gsz; return true;
    }
    __device__ __forceinline__ void a_ready(const Unit&) const {}
    __device__ __forceinline__ void done(const Unit&) const {}
};

__device__ __forceinline__ unsigned cvt_pk_bf16(float lo, float hi) { unsigned r; asm volatile("v_cvt_pk_bf16_f32 %0, %1, %2" : "=v"(r) : "v"(lo), "v"(hi)); return r; }
typedef float f32x2 __attribute__((ext_vector_type(2)));
__device__ __forceinline__ f32x2 relu2_pk(f32x2 v) { f32x2 r; r.x = fmaxf(v.x, 0.f); r.y = fmaxf(v.y, 0.f); return r * r; }

template <int ACT  > struct EpiBf16 {
    static constexpr bool PERM = true, AFTER_DRAIN = false; static_assert(ACT == 0 || ACT == 1, "EpiBf16: ACT is 0 or 1");
    bf16_t* O; int ldc; const float* bias; int bias_bstride; const float* ssq; float eps;
    __device__ __forceinline__ void operator()(const f32x4 (&acc)[2][2][4][2], const Unit& u, int wr, int wc, int fr, int fq) const {
        const int row0 = u.pm * BM + wr * 64 + fr; const int colt = u.pn * BM; bf16_t* base = O;
        const int col0 = colt + wc * 32 + 8 * fq;
        const float* bb = bias ? bias + (size_t)(u.pm >> 4) * bias_bstride : nullptr;
        f32x4 bv[2][2];
#pragma unroll
        for (int bj = 0; bj < 2; ++bj)
#pragma unroll
            for (int n = 0; n < 2; ++n) bv[bj][n] = bb ? *(const f32x4*)(bb + col0 + bj * HALF + 4 * n) : (f32x4){0.f, 0.f, 0.f, 0.f};
        float rsv[2][4];
#pragma unroll
        for (int ai = 0; ai < 2; ++ai)
#pragma unroll
            for (int m = 0; m < 4; ++m) rsv[ai][m] = ssq ? ssq[row0 + ai * HALF + m * 16] : 0.f;
#pragma unroll
        for (int ai = 0; ai < 2; ++ai)
#pragma unroll
            for (int m = 0; m < 4; ++m) { const int row = row0 + ai * HALF + m * 16; bf16_t* rowp = base + (size_t)row * ldc + col0;
                float rs = 1.0f;
                if (ssq) rs = rsqrtf(rsv[ai][m] * (1.0f / 1024.0f) + eps);
#pragma unroll
                for (int bj = 0; bj < 2; ++bj) { f32x4 v0 = acc[ai][bj][m][0] * rs + bv[bj][0], v1 = acc[ai][bj][m][1] * rs + bv[bj][1];
                    if (ACT == 1) { f32x2 a = relu2_pk((f32x2){v0[0], v0[1]}), b = relu2_pk((f32x2){v0[2], v0[3]}), c = relu2_pk((f32x2){v1[0], v1[1]}), d = relu2_pk((f32x2){v1[2], v1[3]});
                        v0 = (f32x4){a.x, a.y, b.x, b.y}; v1 = (f32x4){c.x, c.y, d.x, d.y}; }
                    u32x4 w; w.x = cvt_pk_bf16(v0[0], v0[1]); w.y = cvt_pk_bf16(v0[2], v0[3]); w.z = cvt_pk_bf16(v1[0], v1[1]); w.w = cvt_pk_bf16(v1[2], v1[3]);
                    *(u32x4*)(rowp + bj * HALF) = w; } }
    }
};

struct EpiQKV {
    static constexpr bool PERM = true, AFTER_DRAIN = false;
    bf16_t* O; size_t split_stride; const float* qg; const float* kg; float eps; const float* bias; int bias_bstride; const float* ssq;
    __device__ __forceinline__ void operator()(const f32x4 (&acc)[2][2][4][2], const Unit& u, int wr, int wc, int fr, int fq) const {
        const int t = u.pn >> 2, head = (u.pn & 3) * 4 + wc;
        bf16_t* base = O + (size_t)t * split_stride + head * 64 + 8 * fq;
        const int row0 = u.pm * BM + wr * 64 + fr;
        f32x4 gv[2][2];
        const float* gsrc = (t == 0) ? qg : kg;
#pragma unroll
        for (int bj = 0; bj < 2; ++bj)
#pragma unroll
            for (int n = 0; n < 2; ++n) gv[bj][n] = (t < 2) ? *(const f32x4*)(gsrc + 32 * bj + 8 * fq + 4 * n) : (f32x4){1.f, 1.f, 1.f, 1.f};
        const float qs = (t == 0) ? 0.125f * 1.4426950408889634f : 1.0f;
        const float* bb = bias + (size_t)(u.pm >> 4) * bias_bstride + u.pn * BM + wc * 32 + 8 * fq;
        f32x4 bv[2][2];
#pragma unroll
        for (int bj = 0; bj < 2; ++bj)
#pragma unroll
            for (int n = 0; n < 2; ++n) bv[bj][n] = *(const f32x4*)(bb + bj * HALF + 4 * n);
        float rsv[2][4];
#pragma unroll
        for (int ai = 0; ai < 2; ++ai)
#pragma unroll
            for (int m = 0; m < 4; ++m) rsv[ai][m] = ssq[row0 + ai * HALF + m * 16];
#pragma unroll
        for (int ai = 0; ai < 2; ++ai)
#pragma unroll
            for (int m = 0; m < 4; ++m) {
                float rs;
                rs = rsqrtf(rsv[ai][m] * (1.0f / 1024.0f) + eps);
                f32x4 xv[2][2];
#pragma unroll
                for (int bj = 0; bj < 2; ++bj)
#pragma unroll
                    for (int n = 0; n < 2; ++n) xv[bj][n] = acc[ai][bj][m][n] * rs + bv[bj][n];
                float sc = 1.0f;
                if (t < 2) { float ss = 0.f;
#pragma unroll
                    for (int bj = 0; bj < 2; ++bj)
#pragma unroll
                        for (int n = 0; n < 2; ++n) { const f32x4 x = xv[bj][n]; ss += (x[0] * x[0] + x[1] * x[1]) + (x[2] * x[2] + x[3] * x[3]); }
                    ss += __shfl_xor(ss, 16); ss += __shfl_xor(ss, 32);
                    sc = rsqrtf(ss * (1.0f / 64.0f) + eps) * qs; }
                const int row = row0 + ai * HALF + m * 16;
                if (t < 2) {
                    bf16_t* rowp = base + (size_t)row * 1024;
#pragma unroll
                    for (int bj = 0; bj < 2; ++bj) { const f32x4 v0 = xv[bj][0] * sc * gv[bj][0], v1 = xv[bj][1] * sc * gv[bj][1];
                        u32x4 w; w.x = cvt_pk_bf16(v0[0], v0[1]); w.y = cvt_pk_bf16(v0[2], v0[3]); w.z = cvt_pk_bf16(v1[0], v1[1]); w.w = cvt_pk_bf16(v1[2], v1[3]);
                        *(u32x4*)(rowp + bj * 32) = w; }
                } else {
                    bf16_t* vt = O + 2 * split_stride + ((size_t)((row >> 12) * 16 + head) * 64 + 8 * fq) * 4096 + (row & 4095);
#pragma unroll
                    for (int bj = 0; bj < 2; ++bj)
#pragma unroll
                        for (int n = 0; n < 2; ++n) { const f32x4 v = xv[bj][n]; const unsigned w0 = cvt_pk_bf16(v[0], v[1]), w1 = cvt_pk_bf16(v[2], v[3]);
                            bf16_t* p = vt + (size_t)(32 * bj + 4 * n) * 4096;
                            p[0] = (bf16_t)(w0 & 0xffffu); p[4096] = (bf16_t)(w0 >> 16); p[2 * 4096] = (bf16_t)(w1 & 0xffffu); p[3 * 4096] = (bf16_t)(w1 >> 16); }
                }
            }
    }
};
template <bool BASE_BF16, bool OUT_BF16> struct EpiResGate {
    static constexpr bool PERM = false, AFTER_DRAIN = false;
    const void* base; void* out; const float* gate; int gstride;
    bf16_t* hout; const float* ng; const float* nscale; float* ssq;
    typedef unsigned u32x2e __attribute__((ext_vector_type(2)));
    __device__ __forceinline__ void operator()(const f32x4 (&acc)[2][2][4][2], const Unit& u, int wr, int wc, int fr, int fq) const {
        const int b = u.pm >> 4;
        const int col0 = u.pn * BM + wc * 32 + 4 * fq;
        f32x4 gv[2][2], gm[2][2];
#pragma unroll
        for (int bj = 0; bj < 2; ++bj)
#pragma unroll
            for (int n = 0; n < 2; ++n) { gv[bj][n] = *(const f32x4*)(gate + (size_t)b * gstride + col0 + bj * HALF + n * 16);
                gm[bj][n] = hout ? *(const f32x4*)(ng + col0 + bj * HALF + n * 16) * (*(const f32x4*)(nscale + (size_t)b * gstride + col0 + bj * HALF + n * 16) + 1.0f) : (f32x4){0.f, 0.f, 0.f, 0.f}; }
        constexpr int NB = BASE_BF16 ? 4 : 2;
#pragma unroll
        for (int am = 0; am < 8 / NB; ++am) { const int ai = (am * NB) >> 2, m0 = (am * NB) & 3;
            f32x4 bs[NB][2][2];
#pragma unroll
            for (int mm = 0; mm < NB; ++mm) { const size_t off = (size_t)(u.pm * BM + ai * HALF + wr * 64 + (m0 + mm) * 16 + fr) * 1024 + col0;
#pragma unroll
                for (int bj = 0; bj < 2; ++bj)
#pragma unroll
                    for (int n = 0; n < 2; ++n) {
                        if (BASE_BF16) { const u32x2e r = *(const u32x2e*)((const bf16_t*)base + off + bj * HALF + n * 16);
                            bs[mm][bj][n] = (f32x4){__uint_as_float(r.x << 16), __uint_as_float(r.x & 0xffff0000u), __uint_as_float(r.y << 16), __uint_as_float(r.y & 0xffff0000u)}; }
                        else bs[mm][bj][n] = *(const f32x4*)((const float*)base + off + bj * HALF + n * 16); } }
#pragma unroll
            for (int mm = 0; mm < NB; ++mm) { const int m = m0 + mm; const int row = u.pm * BM + ai * HALF + wr * 64 + m * 16 + fr; const size_t off = (size_t)row * 1024 + col0;
                float ss = 0.f;
#pragma unroll
                for (int bj = 0; bj < 2; ++bj)
#pragma unroll
                    for (int n = 0; n < 2; ++n) {
                        const f32x4 xn = bs[mm][bj][n] + gv[bj][n] * acc[ai][bj][m][n];
                        if (OUT_BF16) *(u32x2e*)((bf16_t*)out + off + bj * HALF + n * 16) = (u32x2e){cvt_pk_bf16(xn[0], xn[1]), cvt_pk_bf16(xn[2], xn[3])};
                        else *(f32x4*)((float*)out + off + bj * HALF + n * 16) = xn;
                        if (hout) { ss += (xn[0] * xn[0] + xn[1] * xn[1]) + (xn[2] * xn[2] + xn[3] * xn[3]); const f32x4 a = xn * gm[bj][n];
                            *(u32x2e*)(hout + off + bj * HALF + n * 16) = (u32x2e){cvt_pk_bf16(a[0], a[1]), cvt_pk_bf16(a[2], a[3])}; } }
                if (hout) { ss += __shfl_xor(ss, 16); ss += __shfl_xor(ss, 32); if (fq == 0) __hip_atomic_fetch_add(ssq + row, ss, __ATOMIC_RELAXED, __HIP_MEMORY_SCOPE_AGENT); } }
        }
    }
};
template <class Epi, class Sched, bool ALIGN_EPI = false, bool SP2 = false>
__device__ __forceinline__ void gemm_phase(PG8_LAS unsigned char* lds, const Gemm g, const Sched& S, const Epi& E) {
    const int tid = threadIdx.x, wid = __builtin_amdgcn_readfirstlane(tid >> 6), lane = tid & 63, wr = wid >> 2, wc = wid & 3, fr = lane & 15, fq = lane >> 4;
    const int K = g.K, nt = K / BK;
    unsigned voffA[2], voffB[2];
#pragma unroll
    for (int i = 0; i < 2; ++i) { int R, C; stage_rc(tid * 16 + i * 8192, R, C); const int Rb = Epi::PERM ? ((R & ~31) + perm32(R & 31)) : R;
        voffA[i] = (unsigned)(R * K + C) * 2u; voffB[i] = (unsigned)(Rb * K + C) * 2u; }
    const size_t kstep = (size_t)(BK * 2);
    const size_t hstep = (size_t)HALF * K * 2;
    const size_t tstep = 2 * hstep;
    const unsigned ldsw = (unsigned)wid * 1024u;
    const int aoff = lds_byte(wr * 64 + fr, fq * 8), boff = lds_byte(wc * 32 + fr, fq * 8);
#define PG8_SA(b, h) (((b) * 2 + (h)) * HTB)
#define PG8_SB(b, h) ((4 + (b) * 2 + (h)) * HTB)
#define PG8_STAGE(bufoff, gbase, voff) do { _Pragma("unroll") for (int _i = 0; _i < 2; ++_i) \
        __builtin_amdgcn_global_load_lds((const unsigned*)((const char*)(gbase) + (voff)[_i]), (PG8_LAS unsigned*)(lds + (bufoff) + ldsw + _i * 8192), 16, 0, 0); } while (0)
#define PG8_LDA(dst, b, h) do { _Pragma("unroll") for (int m = 0; m < 4; ++m) _Pragma("unroll") for (int k = 0; k < 2; ++k) dst[m][k] = *(const PG8_LAS bf16x8*)(lds + PG8_SA(b, h) + aoff + m * 2048 + k * 1024); } while (0)
#define PG8_LDB(dst, b, h) do { _Pragma("unroll") for (int n = 0; n < 2; ++n) _Pragma("unroll") for (int k = 0; k < 2; ++k) dst[n][k] = *(const PG8_LAS bf16x8*)(lds + PG8_SB(b, h) + boff + n * 2048 + k * 1024); } while (0)
#define PG8_MMA(ai, bj, At, Bt) do { __builtin_amdgcn_s_setprio(1); _Pragma("unroll") for (int m = 0; m < 4; ++m) _Pragma("unroll") for (int n = 0; n < 2; ++n) _Pragma("unroll") for (int k = 0; k < 2; ++k) \
        acc[ai][bj][m][n] = __builtin_amdgcn_mfma_f32_16x16x32_bf16(Bt[n][k], At[m][k], acc[ai][bj][m][n], 0, 0, 0); __builtin_amdgcn_s_setprio(0); } while (0)
#define PG8_WAIT_V(n) asm volatile("s_waitcnt vmcnt(" #n ")" ::: "memory")
#define PG8_WAIT_L(n) asm volatile("s_waitcnt lgkmcnt(" #n ")" ::: "memory")
#define PG8_BAR __builtin_amdgcn_s_barrier()
#define PG8_SCHED __builtin_amdgcn_sched_barrier(0)
    Unit cur, nxt; int ui = 0;
    if (!S.next(0, cur)) return;
    f32x4 acc[2][2][4][2];
#pragma unroll
    for (int a = 0; a < 2; ++a)
#pragma unroll
        for (int b = 0; b < 2; ++b)
#pragma unroll
            for (int m = 0; m < 4; ++m)
#pragma unroll
                for (int n = 0; n < 2; ++n) acc[a][b][m][n] = (f32x4){0.f, 0.f, 0.f, 0.f};
    bf16x8 At[4][2], B0[2][2], B1[2][2];
    const char* cA = (const char*)g.A + (size_t)cur.pm * tstep; const char* cB = (const char*)g.Bt + (size_t)cur.pn * tstep;
    S.a_ready(cur);
    if constexpr (SP2) {
        PG8_STAGE(PG8_SB(0, 0), cB, voffB); PG8_STAGE(PG8_SB(0, 1), cB + hstep, voffB); PG8_STAGE(PG8_SA(0, 0), cA, voffA); PG8_STAGE(PG8_SA(0, 1), cA + hstep, voffA);
        if (wr == 1) PG8_BAR;
        PG8_WAIT_V(2); PG8_BAR;
        PG8_STAGE(PG8_SB(1, 0), cB + kstep, voffB); PG8_STAGE(PG8_SA(1, 0), cA + kstep, voffA); PG8_STAGE(PG8_SB(1, 1), cB + hstep + kstep, voffB);
        PG8_WAIT_V(6); PG8_BAR;
    } else {
        PG8_STAGE(PG8_SB(0, 0), cB, voffB); PG8_STAGE(PG8_SA(0, 0), cA, voffA); PG8_STAGE(PG8_SB(0, 1), cB + hstep, voffB); PG8_STAGE(PG8_SA(0, 1), cA + hstep, voffA);
        if (wr == 1) PG8_BAR;
        PG8_WAIT_V(4); PG8_BAR;
        PG8_STAGE(PG8_SB(1, 0), cB + kstep, voffB); PG8_STAGE(PG8_SA(1, 0), cA + kstep, voffA); PG8_STAGE(PG8_SB(1, 1), cB + hstep + kstep, voffB);
        PG8_WAIT_V(6); PG8_BAR;
    }
    for (;;) {
        const bool has_next = S.next(ui + 1, nxt);
        const char* nA = has_next ? (const char*)g.A + (size_t)nxt.pm * tstep : cA; const char* nB = has_next ? (const char*)g.Bt + (size_t)nxt.pn * tstep : cB;
        for (int t = 0; t < nt; t += 2) {
            const bool last = (t == nt - 2);
            const char* a1 = cA + (size_t)(t + 1) * kstep;
            const char* a2 = last ? nA : cA + (size_t)(t + 2) * kstep; const char* b2 = last ? nB : cB + (size_t)(t + 2) * kstep;
            const char* a3 = a2 + kstep; const char* b3 = b2 + kstep;
            if (last && has_next) S.a_ready(nxt);
            if constexpr (SP2) {
            PG8_LDB(B0, 0, 0); PG8_LDB(B1, 0, 1); PG8_SCHED; PG8_LDA(At, 0, 0); PG8_STAGE(PG8_SA(1, 1), a1 + hstep, voffA);
            PG8_WAIT_V(8); PG8_WAIT_L(0); PG8_BAR; PG8_MMA(0, 0, At, B0); PG8_MMA(0, 1, At, B1); PG8_BAR; PG8_SCHED;
            PG8_LDA(At, 0, 1); PG8_STAGE(PG8_SB(0, 0), b2, voffB); PG8_STAGE(PG8_SB(0, 1), b2 + hstep, voffB); PG8_STAGE(PG8_SA(0, 0), a2, voffA);
            PG8_WAIT_V(8); PG8_WAIT_L(0); PG8_BAR; PG8_MMA(1, 0, At, B0); PG8_MMA(1, 1, At, B1); PG8_BAR; PG8_SCHED;
            PG8_LDB(B0, 1, 0); PG8_LDB(B1, 1, 1); PG8_SCHED; PG8_LDA(At, 1, 0); PG8_STAGE(PG8_SA(0, 1), a2 + hstep, voffA);
            PG8_WAIT_V(8); PG8_WAIT_L(0); PG8_BAR; PG8_MMA(0, 0, At, B0); PG8_MMA(0, 1, At, B1); PG8_BAR; PG8_SCHED;
            PG8_LDA(At, 1, 1); PG8_STAGE(PG8_SB(1, 0), b3, voffB); PG8_STAGE(PG8_SB(1, 1), b3 + hstep, voffB); PG8_STAGE(PG8_SA(1, 0), a3, voffA);
            PG8_WAIT_V(8); PG8_WAIT_L(0); PG8_BAR; PG8_MMA(1, 0, At, B0); PG8_MMA(1, 1, At, B1); PG8_BAR; PG8_SCHED;
            } else {
            PG8_LDB(B0, 0, 0); PG8_SCHED; PG8_LDA(At, 0, 0); PG8_STAGE(PG8_SA(1, 1), a1 + hstep, voffA);
            PG8_WAIT_L(8); PG8_BAR; PG8_WAIT_L(0); PG8_MMA(0, 0, At, B0); PG8_BAR; PG8_SCHED;
            PG8_LDB(B1, 0, 1); PG8_STAGE(PG8_SB(0, 0), b2, voffB);
            PG8_BAR; PG8_WAIT_L(0); PG8_MMA(0, 1, At, B1); PG8_BAR;
            PG8_LDA(At, 0, 1); PG8_STAGE(PG8_SA(0, 0), a2, voffA);
            PG8_BAR; PG8_WAIT_L(0); PG8_MMA(1, 0, At, B0); PG8_BAR; PG8_SCHED;
            PG8_STAGE(PG8_SB(0, 1), b2 + hstep, voffB);
            PG8_WAIT_V(6); PG8_BAR; PG8_MMA(1, 1, At, B1); PG8_BAR;
            PG8_LDB(B0, 1, 0); PG8_SCHED; PG8_LDA(At, 1, 0); PG8_STAGE(PG8_SA(0, 1), a2 + hstep, voffA);
            PG8_WAIT_L(8); PG8_BAR; PG8_WAIT_L(0); PG8_MMA(0, 0, At, B0); PG8_BAR; PG8_SCHED;
            PG8_LDB(B1, 1, 1); PG8_STAGE(PG8_SB(1, 0), b3, voffB);
            PG8_BAR; PG8_WAIT_L(0); PG8_MMA(0, 1, At, B1); PG8_BAR;
            PG8_LDA(At, 1, 1); PG8_STAGE(PG8_SA(1, 0), a3, voffA);
            PG8_BAR; PG8_WAIT_L(0); PG8_MMA(1, 0, At, B0); PG8_BAR; PG8_SCHED;
            PG8_STAGE(PG8_SB(1, 1), b3 + hstep, voffB);
            PG8_WAIT_V(6); PG8_BAR; PG8_MMA(1, 1, At, B1); PG8_BAR;
            }
        }
        if constexpr (ALIGN_EPI) { if (wr == 0) PG8_BAR; }
        if constexpr (!Epi::AFTER_DRAIN) { E(acc, cur, wr, wc, fr, fq); S.done(cur); }
        if (!has_next) break;
#pragma unroll
        for (int a = 0; a < 2; ++a)
#pragma unroll
            for (int b = 0; b < 2; ++b)
#pragma unroll
                for (int m = 0; m < 4; ++m)
#pragma unroll
                    for (int n = 0; n < 2; ++n) acc[a][b][m][n] = (f32x4){0.f, 0.f, 0.f, 0.f};
        cur = nxt; cA = nA; cB = nB; ++ui;
        if constexpr (ALIGN_EPI) { if (wr == 1) PG8_BAR; }
    }
    PG8_WAIT_V(0);
    if constexpr (!ALIGN_EPI) { if (wr == 0) PG8_BAR; }
    PG8_BAR;
    if constexpr (Epi::AFTER_DRAIN) { E.fused(acc, cur, wr, wc, fr, fq, lds, wid, lane); S.done(cur); }
#undef PG8_SA
#undef PG8_SB
#undef PG8_STAGE
#undef PG8_LDA
#undef PG8_LDB
#undef PG8_MMA
#undef PG8_WAIT_V
#undef PG8_WAIT_L
#undef PG8_BAR
#undef PG8_SCHED
}
}

#ifndef MK_N_LAUNCHES
#define MK_N_LAUNCHES 1
#endif
#define LAS __attribute__((address_space(3)))
typedef unsigned short bf16;
typedef short bf16x8 __attribute__((ext_vector_type(8)));
typedef short s16x4 __attribute__((ext_vector_type(4)));
typedef float f32x4 __attribute__((ext_vector_type(4)));
typedef float f32x16 __attribute__((ext_vector_type(16)));
typedef unsigned u32x4 __attribute__((ext_vector_type(4)));
typedef unsigned u32x2 __attribute__((ext_vector_type(2)));
typedef float f32x2_t __attribute__((ext_vector_type(2)));
typedef __bf16 bf16x2_t __attribute__((ext_vector_type(2)));
#define MFMA32(a, b, c) __builtin_amdgcn_mfma_f32_32x32x16_bf16((a), (b), (c), 0, 0, 0)

constexpr int NWAVES = 8, NTHR = 512;
constexpr int BATCH = 8, SEQ = 4096, D = 1024, M = BATCH * SEQ, FF = 4096, AB_IN = 3584, NQKV = 3072;
constexpr int NHU = 2048;
constexpr float EPS = 1e-6f;
constexpr size_t MiB = 1u << 20;
constexpr size_t WS_MOD = 1 * MiB;
constexpr size_t WS_WIN = 2 * MiB, WS_WOUT = 9 * MiB, WS_W1_0 = 11 * MiB, WS_W2_0 = 19 * MiB, WS_WQKV = 27 * MiB, WS_WOC = 33 * MiB, WS_W1_1 = 35 * MiB, WS_W2_1 = 43 * MiB;
constexpr size_t WS_HBUF = 52 * MiB;
constexpr size_t WS_YCAT = 116 * MiB;
constexpr size_t WS_BIG = 180 * MiB;
constexpr size_t WS_INTRA = 404 * MiB;
constexpr size_t WS_XRES = 436 * MiB;
constexpr size_t WS_QE = 468 * MiB;
constexpr size_t WS_DLAST = 500 * MiB;
constexpr size_t WS_SSQ = 501 * MiB;
constexpr size_t WS_SW = 503 * MiB;
constexpr size_t WS_END = 504 * MiB;
constexpr size_t WS_CTL = 0, CTL_ZERO_BYTES = 16 * 1024;
constexpr int LDS_BYTES = 147456 + 64;
constexpr int LDS_MISC_OFF = 147456;

__device__ __forceinline__ float bf2f(bf16 v) { return __uint_as_float((unsigned)v << 16); }
__device__ __forceinline__ unsigned cvtpk(float lo, float hi) { f32x2_t v = {lo, hi}; bf16x2_t b = __builtin_convertvector(v, bf16x2_t); return __builtin_bit_cast(unsigned, b); }
__device__ __forceinline__ bf16 f2bf(float f) { return (bf16)(cvtpk(f, 0.f) & 0xffffu); }
template <int S> __device__ __forceinline__ bf16x8 pack8(const f32x16& x) {
    u32x4 p; p[0] = cvtpk(x[8 * S], x[8 * S + 1]); p[1] = cvtpk(x[8 * S + 2], x[8 * S + 3]); p[2] = cvtpk(x[8 * S + 4], x[8 * S + 5]); p[3] = cvtpk(x[8 * S + 6], x[8 * S + 7]);
    return __builtin_bit_cast(bf16x8, p);
}
__device__ __forceinline__ int crow(int r, int hi) { return (r & 3) + 8 * (r >> 2) + 4 * hi; }
__device__ __forceinline__ float wave_sum(float v) {
#pragma unroll
    for (int o = 1; o < 64; o <<= 1) v += __shfl_xor(v, o);
    return v;
}
__device__ __forceinline__ f32x16 zero16() { f32x16 z;
#pragma unroll
    for (int i = 0; i < 16; ++i) z[i] = 0.f;
    return z; }

#define XB_TMO      128
#define XB_XCNT(j)  (256  + 64 * (j))
#define XB_XSUB(j)  (1280 + 64 * (j))
#define XB_XGEN(j)  (2304 + 64 * (j))
#define XB_TOP      3328
#define XB_TOPGEN   3392
#define XCD_BAR_WORDS 3456
#define XB_SPIN_CAP (1u << 18)

__device__ __forceinline__ unsigned xb_ld(unsigned* p)              { return __hip_atomic_load(p, __ATOMIC_RELAXED, __HIP_MEMORY_SCOPE_AGENT); }
__device__ __forceinline__ unsigned xb_add(unsigned* p, unsigned v) { return __hip_atomic_fetch_add(p, v, __ATOMIC_RELAXED, __HIP_MEMORY_SCOPE_AGENT); }
__device__ __forceinline__ unsigned xb_xcc_id() { return (unsigned)__builtin_amdgcn_s_getreg((3 << 11) | 20) & 0xFu; }
#define XB_SPIN(cond, bar) do { unsigned _sp = 0; while (cond) { __builtin_amdgcn_s_sleep(1); \
    if ((++_sp & 255u) == 0u) { if (xb_ld(&(bar)[XB_TMO])) break; if (_sp > XB_SPIN_CAP) { atomicAdd(&(bar)[XB_TMO], 1u); break; } } } } while (0)

struct XcdBarrier {
    unsigned* bar; unsigned x;
    volatile LAS unsigned* st;
};

__device__ __forceinline__ XcdBarrier xcd_barrier_post(unsigned* bar, volatile LAS unsigned* st) {
    XcdBarrier b; b.bar = bar; b.x = xb_xcc_id(); b.st = st;
    if (threadIdx.x == 0) (void)xb_add(&bar[XB_XCNT(b.x)], 1u);
    return b;
}
__device__ __forceinline__ void xcd_barrier_complete(unsigned* bar, unsigned x, unsigned& nloc, unsigned& nx) {
    const unsigned G = gridDim.x * gridDim.y * gridDim.z;
    unsigned sum, cnt, mine, sp = 0u;
    for (;;) {
        sum = 0u; cnt = 0u; mine = 0u;
#pragma unroll
        for (unsigned j = 0; j < 16; ++j) { const unsigned c = xb_ld(&bar[XB_XCNT(j)]); sum += c; cnt += (c > 0u) ? 1u : 0u; mine = (j == x) ? c : mine; }
        if (sum == G) break;
        __builtin_amdgcn_s_sleep(1);
        if ((++sp & 255u) == 0u) { if (xb_ld(&bar[XB_TMO])) break; if (sp > XB_SPIN_CAP) { atomicAdd(&bar[XB_TMO], 1u); break; } }
    }
    nloc = mine > 0u ? mine : 1u; nx = cnt > 0u ? cnt : 1u;
}

__device__ __forceinline__ void xcd_barrier(const XcdBarrier& b) {
    asm volatile("s_waitcnt vmcnt(0)" ::: "memory");
    __syncthreads();
    if (threadIdx.x == 0) {
        unsigned* bar = b.bar;
        __builtin_amdgcn_s_waitcnt(0);
        unsigned nloc = b.st[0], nx = b.st[1];
        if (nloc == 0u) { xcd_barrier_complete(bar, b.x, nloc, nx); b.st[0] = nloc; b.st[1] = nx; }
        const unsigned old = xb_add(&bar[XB_XSUB(b.x)], 1u);
        const unsigned gen = old / nloc;
        if (old + 1u == (gen + 1u) * nloc) {
            __builtin_amdgcn_fence(__ATOMIC_RELEASE, "agent");
            asm volatile("s_waitcnt vmcnt(0)" ::: "memory");
            const unsigned og = xb_add(&bar[XB_TOP], 1u);
            const unsigned tg = og / nx;
            if (og + 1u == (tg + 1u) * nx) xb_add(&bar[XB_TOPGEN], 1u);
            else XB_SPIN(xb_ld(&bar[XB_TOPGEN]) == tg, bar);
            __builtin_amdgcn_fence(__ATOMIC_ACQUIRE, "agent");
            xb_add(&bar[XB_XGEN(b.x)], 1u);
            asm volatile("s_waitcnt vmcnt(0)" ::: "memory");
        } else {
            XB_SPIN(xb_ld(&bar[XB_XGEN(b.x)]) == gen, bar);
            __builtin_amdgcn_fence(__ATOMIC_ACQUIRE, "agent");
            asm volatile("s_waitcnt vmcnt(0)" ::: "memory");
        }
    }
    __syncthreads();
}

__device__ __forceinline__ void transpose_item(const float* W, int K, int N, bf16* WT, LAS float* scr, int item, int lane, bool gperm) {
    const int nblk = N / 32, kb = item / nblk, nb = item % nblk, k0 = 64 * kb, n0 = 32 * nb;
    const int lg = nb & 7, p0 = gperm ? ((nb & ~7) + 4 * (lg & 1) + (lg >> 1)) * 32 : n0;
    float wv[32];
#pragma unroll
    for (int i = 0; i < 32; ++i) wv[i] = W[(size_t)(k0 + 2 * i + (lane >> 5)) * N + n0 + (lane & 31)];
#pragma unroll
    for (int i = 0; i < 32; ++i) scr[(2 * i + (lane >> 5)) * 33 + (lane & 31)] = wv[i];
    asm volatile("s_waitcnt lgkmcnt(0)" ::: "memory");
    const int c = lane & 7;
#pragma unroll
    for (int j = 0; j < 4; ++j) { const int n = (lane >> 3) + 8 * j; const LAS float* s = scr + (8 * c) * 33 + n;
        u32x4 o; o.x = cvtpk(s[0 * 33], s[1 * 33]); o.y = cvtpk(s[2 * 33], s[3 * 33]); o.z = cvtpk(s[4 * 33], s[5 * 33]); o.w = cvtpk(s[6 * 33], s[7 * 33]);
        *(u32x4*)(WT + (size_t)(p0 + n) * K + k0 + 8 * c) = o; }
    asm volatile("s_waitcnt lgkmcnt(0)" ::: "memory");
}
struct WJob { const float* W; bf16* WT; int K, N; bool gperm; };

__device__ __forceinline__ void phase_prologue(LAS unsigned char* lds, const float* const* in, unsigned char* ws) {
    const int tid = threadIdx.x, lane = tid & 63, wid = tid >> 6;
    {
        LAS float* cact = (LAS float*)lds;
        LAS float* red = (LAS float*)(lds + 32768);
        const float* cvec = in[1]; const float* ada_w = in[2]; const float* ada_b = in[3]; float* mod = (float*)(ws + WS_MOD);
        for (int i = tid; i < 8192; i += NTHR) { const float c = cvec[i]; cact[i] = c / (1.f + __expf(-c)); }
        __syncthreads();
        for (int it = blockIdx.x; it < 192; it += gridDim.x) {
            const int l = it / 96, n0 = (it % 96) * 64, col = tid & 63, kg = tid >> 6;
            float acc[8];
#pragma unroll
            for (int b = 0; b < 8; ++b) acc[b] = 0.f;
            const float* w = ada_w + (size_t)l * 1024 * 6144 + (size_t)(kg * 128) * 6144 + n0 + col;
#pragma unroll 32
            for (int kk = 0; kk < 128; ++kk) { const float wv = w[(size_t)kk * 6144];
#pragma unroll
                for (int b = 0; b < 8; ++b) acc[b] += cact[b * 1024 + kg * 128 + kk] * wv; }
#pragma unroll
            for (int b = 0; b < 8; ++b) red[(kg * 8 + b) * 64 + col] = acc[b];
            __syncthreads();
            { const int b = tid >> 6; float s = 0.f;
#pragma unroll
              for (int g = 0; g < 8; ++g) s += red[(g * 8 + b) * 64 + col];
              mod[(size_t)(l * 8 + b) * 6144 + n0 + col] = s + ada_b[l * 6144 + n0 + col]; }
            __syncthreads();
        }
        __syncthreads();
    }
    {
        LAS float* scr = (LAS float*)(lds + wid * 16384);
        const int gw = blockIdx.x * NWAVES + wid, NGW = gridDim.x * NWAVES;
        const WJob jobs[8] = {
            {in[6], (bf16*)(ws + WS_WIN), 1024, AB_IN, false}, {in[10], (bf16*)(ws + WS_WOUT), 1024, 1024, false}, {in[11], (bf16*)(ws + WS_WQKV), 1024, NQKV, true}, {in[14], (bf16*)(ws + WS_WOC), 1024, 1024, false},
            {in[15], (bf16*)(ws + WS_W1_0), 1024, FF, false}, {in[15] + (size_t)1024 * FF, (bf16*)(ws + WS_W1_1), 1024, FF, false},
            {in[16], (bf16*)(ws + WS_W2_0), FF, 1024, false}, {in[16] + (size_t)1024 * FF, (bf16*)(ws + WS_W2_1), FF, 1024, false}};
        int base = 0;
#pragma unroll
        for (int j = 0; j < 8; ++j) {
            const int ni = (jobs[j].K / 64) * (jobs[j].N / 32);
            int first = (gw - base % NGW + NGW) % NGW;
            for (int i = first; i < ni; i += NGW) transpose_item(jobs[j].W, jobs[j].K, jobs[j].N, jobs[j].WT, scr, i, lane, jobs[j].gperm);
            base += ni;
        }
    }
}

__device__ __forceinline__ void phase_norm(const float* x, const float* g, const float* shift, const float* scale, bf16* hout) {
    const int tid = threadIdx.x, lane = tid & 63, wid = tid >> 6;
    const int gw = blockIdx.x * NWAVES + wid, NGW = gridDim.x * NWAVES;
    for (int r0 = gw * 16; r0 < M; r0 += NGW * 16) {
        const int b = r0 / SEQ;
        f32x4 gm[4], sh[4];
#pragma unroll
        for (int j = 0; j < 4; ++j) { const int col = 4 * lane + 256 * j; const f32x4 gg = *(const f32x4*)(g + col), sc = *(const f32x4*)(scale + (size_t)b * 6144 + col);
            gm[j] = gg * (sc + 1.0f); sh[j] = *(const f32x4*)(shift + (size_t)b * 6144 + col); }
#pragma unroll 4
        for (int r = 0; r < 16; ++r) {
            const size_t row = (size_t)(r0 + r);
            f32x4 v[4]; float ss = 0.f;
#pragma unroll
            for (int j = 0; j < 4; ++j) { v[j] = *(const f32x4*)(x + row * D + 4 * lane + 256 * j); ss += (v[j].x * v[j].x + v[j].y * v[j].y) + (v[j].z * v[j].z + v[j].w * v[j].w); }
            const float rstd = rsqrtf(wave_sum(ss) * (1.f / D) + EPS);
#pragma unroll
            for (int j = 0; j < 4; ++j) { const f32x4 o = v[j] * rstd * gm[j] + sh[j]; u32x2 w; w.x = cvtpk(o.x, o.y); w.y = cvtpk(o.z, o.w);
                *(u32x2*)(hout + row * D + 4 * lane + 256 * j) = w; }
        }
    }
}

__device__ __forceinline__ void phase_shiftw(const bf16* __restrict__ Wt, int N, const float* __restrict__ shift  , float* __restrict__ sW  ) {
    const int tid = threadIdx.x, lane = tid & 63, wid = tid >> 6;
    const int gw = blockIdx.x * NWAVES + wid, NGW = gridDim.x * NWAVES;
    for (int n = gw; n < N; n += NGW) {
        const bf16x8 w0 = *(const bf16x8*)(Wt + (size_t)n * 1024 + 16 * lane), w1 = *(const bf16x8*)(Wt + (size_t)n * 1024 + 16 * lane + 8);
        float wf[16];
#pragma unroll
        for (int j = 0; j < 8; ++j) { wf[j] = bf2f((bf16)w0[j]); wf[8 + j] = bf2f((bf16)w1[j]); }
#pragma unroll
        for (int b = 0; b < 8; ++b) { const f32x4* sp = (const f32x4*)(shift + (size_t)b * 6144 + 16 * lane); float s = 0.f;
#pragma unroll
            for (int q = 0; q < 4; ++q) { const f32x4 sv = sp[q]; s += (sv[0] * wf[4 * q] + sv[1] * wf[4 * q + 1]) + (sv[2] * wf[4 * q + 2] + sv[3] * wf[4 * q + 3]); }
            s = wave_sum(s);
            if (lane == 0) sW[(size_t)b * N + n] = s; }
    }
}

#define LDS_BARRIER() do { asm volatile("s_waitcnt lgkmcnt(0)" ::: "memory"); __builtin_amdgcn_s_barrier(); asm volatile("" ::: "memory"); } while (0)

__device__ __forceinline__ void phase_conv(const bf16* u, const float* conv_w, bf16* ycat) {
    const int tid = threadIdx.x, cgp = tid & 63, rg = tid >> 6;
    float w0[8], w1[8], w2[8];
#pragma unroll
    for (int j = 0; j < 8; ++j) { w0[j] = conv_w[8 * cgp + j]; w1[j] = conv_w[512 + 8 * cgp + j]; w2[j] = conv_w[1024 + 8 * cgp + j]; }
    for (int item = blockIdx.x; item < M / 32; item += gridDim.x) {
        const size_t r0 = (size_t)item * 32 + 4 * rg;
        const bool hasprev = ((int)(r0 & (SEQ - 1))) >= 2;
        const bf16* base = u + r0 * AB_IN + 8 * cgp;
        bf16x8 ac[6], ah[6], ab[4];
#pragma unroll
        for (int i = 0; i < 6; ++i) { if (i >= 2 || hasprev) { ac[i] = *(const bf16x8*)(base + (ptrdiff_t)(i - 2) * AB_IN + 512); ah[i] = *(const bf16x8*)(base + (ptrdiff_t)(i - 2) * AB_IN + 1024); }
            else { ac[i] = (bf16x8){0, 0, 0, 0, 0, 0, 0, 0}; ah[i] = ac[i]; } }
#pragma unroll
        for (int i = 0; i < 4; ++i) ab[i] = *(const bf16x8*)(base + (size_t)i * AB_IN);
        float pm2[8], pm1[8];
#pragma unroll
        for (int j = 0; j < 8; ++j) { pm2[j] = bf2f((bf16)ac[0][j]) * bf2f((bf16)ah[0][j]); pm1[j] = bf2f((bf16)ac[1][j]) * bf2f((bf16)ah[1][j]); }
#pragma unroll
        for (int i = 0; i < 4; ++i) { float y[8];
#pragma unroll
            for (int j = 0; j < 8; ++j) { const float p = bf2f((bf16)ac[i + 2][j]) * bf2f((bf16)ah[i + 2][j]); y[j] = bf2f((bf16)ab[i][j]) * (w0[j] * pm2[j] + w1[j] * pm1[j] + w2[j] * p); pm2[j] = pm1[j]; pm1[j] = p; }
            *(u32x4*)(ycat + (r0 + i) * D + 8 * cgp) = (u32x4){cvtpk(y[0], y[1]), cvtpk(y[2], y[3]), cvtpk(y[4], y[5]), cvtpk(y[6], y[7])}; }
    }
}

__device__ __forceinline__ void phase_hgrn_a(LAS unsigned char* lds, const bf16* u, const float* lb_logits,
                                             bf16* Ubuf, bf16* qeb, float* dlast, bf16* intra) {
    const int tid = threadIdx.x, lane = tid & 63, wid = tid >> 6, r32 = lane & 31, hi = lane >> 5;
    LAS bf16* qm = (LAS bf16*)(lds);
    LAS bf16* km = (LAS bf16*)(lds + 17408);
    LAS bf16* klT = (LAS bf16*)(lds + 34816);
    LAS bf16* vT = (LAS bf16*)(lds + 34816 + 18432);
    LAS float* part = (LAS float*)(lds + 71680);
    LAS bf16* hfR = (LAS bf16*)(lds + 73728);
    LAS bf16* qR = (LAS bf16*)(lds + 73728 + 17408);
    LAS bf16* vR = (LAS bf16*)(lds + 73728 + 34816);
    LAS bf16* hfR2 = (LAS bf16*)(lds + 73728 + 52224);
    const int ch = tid & 127, tq = tid >> 7;
    const int srow = tid >> 4, sseg = tid & 15;
    u32x4 R[6];
#define HG_LOAD(unit_) do { const int bh_ = (unit_) >> 6, c_ = (unit_) & 63; const bf16* p_ = u + ((size_t)(bh_ >> 2) * SEQ + (size_t)c_ * 64 + srow) * AB_IN + (bh_ & 3) * 128 + 8 * sseg; \
        R[0] = *(const u32x4*)(p_ + 2048); R[1] = *(const u32x4*)(p_ + 2048 + (size_t)32 * AB_IN); R[2] = *(const u32x4*)(p_ + 1536); R[3] = *(const u32x4*)(p_ + 1536 + (size_t)32 * AB_IN); \
        R[4] = *(const u32x4*)(p_ + 2560); R[5] = *(const u32x4*)(p_ + 2560 + (size_t)32 * AB_IN); } while (0)
    if ((int)blockIdx.x < NHU) HG_LOAD(blockIdx.x);
    float lbh[4];
#pragma unroll
    for (int hh = 0; hh < 4; ++hh) { const int f = hh * 128 + ch; const float l0 = lb_logits[f], l1 = lb_logits[512 + f], l2 = lb_logits[1024 + f]; const float mx = fmaxf(l0, fmaxf(l1, l2));
        const float e0 = __expf(l0 - mx), e1 = __expf(l1 - mx), e2 = __expf(l2 - mx); lbh[hh] = e0 / (e0 + e1 + e2); }
#define HG_PARK_HF(HB) do { *(LAS u32x4*)((HB) + srow * 136 + 8 * sseg) = R[0]; *(LAS u32x4*)((HB) + (srow + 32) * 136 + 8 * sseg) = R[1]; } while (0)
#define HG_PARK_QV() do { *(LAS u32x4*)(qR + srow * 136 + 8 * sseg) = R[2]; *(LAS u32x4*)(qR + (srow + 32) * 136 + 8 * sseg) = R[3]; \
        *(LAS u32x4*)(vR + srow * 136 + 8 * sseg) = R[4]; *(LAS u32x4*)(vR + (srow + 32) * 136 + 8 * sseg) = R[5]; } while (0)
#define HG_S1(unit_, HB) do { const int h_ = ((unit_) >> 6) & 3; const float lb_ = h_ == 0 ? lbh[0] : h_ == 1 ? lbh[1] : h_ == 2 ? lbh[2] : lbh[3]; const float oml_ = 1.f - lb_; float run_ = 0.f; \
        _Pragma("unroll") for (int i = 0; i < 16; ++i) { float hf = bf2f((HB)[(16 * tq + i) * 136 + ch]); hf = fminf(fmaxf(hf, -40.f), 40.f); \
            const float e = __expf(-hf), sig = __builtin_amdgcn_rcpf(1.f + e); lf[i] = __logf(lb_ + oml_ * sig); kv[i] = oml_ * e * sig; run_ += lf[i]; } \
        part[tq * 128 + ch] = run_; } while (0)
    float lf[16], kv[16];
    if ((int)blockIdx.x < NHU) { HG_PARK_HF(hfR); HG_PARK_QV(); if ((int)blockIdx.x + (int)gridDim.x < NHU) HG_LOAD(blockIdx.x + gridDim.x); LDS_BARRIER(); HG_S1((int)blockIdx.x, hfR); LDS_BARRIER(); }
    LAS bf16* hfn = hfR2;
    for (int unit = blockIdx.x; unit < NHU; unit += gridDim.x) {
        const bool has_next = unit + (int)gridDim.x < NHU;
        if (has_next) HG_PARK_HF(hfn);
        const float p0 = part[ch], p1 = part[128 + ch], p2 = part[256 + ch], p3 = part[384 + ch];
        const float off = (tq > 0 ? p0 : 0.f) + (tq > 1 ? p1 : 0.f) + (tq > 2 ? p2 : 0.f), bmid = p0 + p1, blast = (p0 + p1) + (p2 + p3);
        if (tq == 0) dlast[(size_t)unit * 128 + ch] = __expf(blast);
        {
            bf16* qep = qeb + ((size_t)unit * 64 + 16 * tq) * 128 + ch;
            float bb = off;
            const float emid = __expf(bmid), iemid = __expf(-bmid), elast = __expf(blast);
#pragma unroll
            for (int i4 = 0; i4 < 4; ++i4) {
                float klv[4]; unsigned vr[4];
#pragma unroll
                for (int e4 = 0; e4 < 4; ++e4) { const int i = 4 * i4 + e4, t = 16 * tq + i;
                    bb += lf[i]; const float q = bf2f(qR[t * 136 + ch]);
                    const float eb = __expf(bb), ieb = __builtin_amdgcn_rcpf(eb);
                    const float qe = q * eb, ki = kv[i] * ieb;
                    qep[(size_t)i * 128] = f2bf(qe);
                    qm[t * 136 + ch] = f2bf(qe * iemid);
                    km[t * 136 + ch] = f2bf(ki * emid);
                    klv[e4] = ki * elast;
                    vr[e4] = vR[t * 136 + ch]; }
                *(LAS u32x2*)(klT + ch * 72 + 16 * tq + 4 * i4) = (u32x2){cvtpk(klv[0], klv[1]), cvtpk(klv[2], klv[3])};
                *(LAS u32x2*)(vT + ch * 72 + 16 * tq + 4 * i4) = (u32x2){vr[0] | (vr[1] << 16), vr[2] | (vr[3] << 16)};
            }
        }
        LDS_BARRIER();
        if (has_next) { HG_PARK_QV(); if (unit + 2 * (int)gridDim.x < NHU) HG_LOAD(unit + 2 * gridDim.x); }
        HG_S1(has_next ? unit + (int)gridDim.x : unit, hfn);
        hfn = (hfn == hfR2) ? hfR : hfR2;
        {
            const int tblk = wid & 1, vblk = wid >> 1;
            f32x16 acc = zero16();
#pragma unroll
            for (int sblk = 0; sblk < 2; ++sblk) if (sblk <= tblk) {
                f32x16 sT = zero16();
#pragma unroll
                for (int k8 = 0; k8 < 8; ++k8) { const bf16x8 a = *(const LAS bf16x8*)(km + (32 * sblk + r32) * 136 + 16 * k8 + 8 * hi);
                    const bf16x8 bq = *(const LAS bf16x8*)(qm + (32 * tblk + r32) * 136 + 16 * k8 + 8 * hi); sT = MFMA32(a, bq, sT); }
                if (sblk == tblk) {
#pragma unroll
                    for (int r = 0; r < 16; ++r) if (crow(r, hi) > r32) sT[r] = 0.f;
                }
                { const bf16x8 xs = pack8<0>(sT); const LAS bf16* vb = vT + (32 * vblk + r32) * 72 + 32 * sblk + 4 * hi;
                  const s16x4 lo = *(const LAS s16x4*)(vb), h4 = *(const LAS s16x4*)(vb + 8); const bf16x8 pb = __builtin_shufflevector(lo, h4, 0, 1, 2, 3, 4, 5, 6, 7); acc = MFMA32(xs, pb, acc); }
                { const bf16x8 xs = pack8<1>(sT); const LAS bf16* vb = vT + (32 * vblk + r32) * 72 + 32 * sblk + 16 + 4 * hi;
                  const s16x4 lo = *(const LAS s16x4*)(vb), h4 = *(const LAS s16x4*)(vb + 8); const bf16x8 pb = __builtin_shufflevector(lo, h4, 0, 1, 2, 3, 4, 5, 6, 7); acc = MFMA32(xs, pb, acc); }
            }
#pragma unroll
            for (int r = 0; r < 16; ++r) intra[((size_t)unit * 64 + 32 * tblk + crow(r, hi)) * 128 + 32 * vblk + r32] = f2bf(acc[r]);
#pragma unroll
            for (int kb2 = 0; kb2 < 2; ++kb2) { const int kblk = 2 * (wid & 1) + kb2, vb = wid >> 1;
                f32x16 ua = zero16();
#pragma unroll
                for (int i = 0; i < 4; ++i) { const bf16x8 a = *(const LAS bf16x8*)(vT + (32 * vb + r32) * 72 + 16 * i + 8 * hi);
                    const bf16x8 bb = *(const LAS bf16x8*)(klT + (32 * kblk + r32) * 72 + 16 * i + 8 * hi); ua = MFMA32(a, bb, ua); }
#pragma unroll
                for (int r = 0; r < 16; ++r) Ubuf[(size_t)unit * 16384 + (size_t)(32 * vb + crow(r, hi)) * 128 + 32 * kblk + r32] = f2bf(ua[r]);
            }
        }
        LDS_BARRIER();
    }
#undef HG_LOAD
#undef HG_PARK_HF
#undef HG_PARK_QV
#undef HG_S1
}

__device__ __forceinline__ void phase_hgrn_scan(const bf16* __restrict__ Ubuf, const float* __restrict__ dlast, bf16* __restrict__ Sprev) {
    for (int gid = blockIdx.x * NTHR + threadIdx.x; gid < 32 * 4096; gid += gridDim.x * NTHR) {
        const int bh = gid >> 12, rem = gid & 4095, v = rem >> 5, k4 = (rem & 31) * 4;
        f32x4 S = (f32x4){0.f, 0.f, 0.f, 0.f};
#pragma unroll 8
        for (int c = 0; c < 64; ++c) { const size_t unit = (size_t)bh * 64 + c;
            const u32x2 ur = *(const u32x2*)(Ubuf + unit * 16384 + v * 128 + k4); const f32x4 d = *(const f32x4*)(dlast + unit * 128 + k4);
            const f32x4 U = (f32x4){__uint_as_float(ur.x << 16), __uint_as_float(ur.x & 0xffff0000u), __uint_as_float(ur.y << 16), __uint_as_float(ur.y & 0xffff0000u)};
            u32x2 w; w.x = cvtpk(S.x, S.y); w.y = cvtpk(S.z, S.w); *(u32x2*)(Sprev + unit * 16384 + v * 128 + k4) = w;
            S = d * S + U; }
    }
}

__device__ __forceinline__ void phase_hgrn_c(LAS unsigned char* lds, const bf16* u, const bf16* qeb, const bf16* Sprev, const bf16* intra, const float* hg_norm, bf16* ycat) {
    const int tid = threadIdx.x, lane = tid & 63, wid = tid >> 6, r32 = lane & 31, hi = lane >> 5;
    LAS float* ob = (LAS float*)lds;
    LAS bf16* qeT = (LAS bf16*)(lds + 33792);
    LAS bf16* spT = (LAS bf16*)(lds + 33792 + 17408);
    LAS bf16* inT = (LAS bf16*)(lds + 33792 + 17408 + 34816);
    const int tblk = wid & 1, vblk = wid >> 1;
    const int nt = tid >> 3, seg = tid & 7;
    const int srow = tid >> 4, sseg = tid & 15;
    u32x4 sq[2], sp[4], si[2]; bf16x8 g0, g1;
#define HC_LOAD(unit_) do { const int un_ = (unit_); const int bh_ = un_ >> 6, c_ = un_ & 63; \
        _Pragma("unroll") for (int i = 0; i < 2; ++i) { sq[i] = *(const u32x4*)(qeb + ((size_t)un_ * 64 + srow + 32 * i) * 128 + 8 * sseg); si[i] = *(const u32x4*)(intra + ((size_t)un_ * 64 + srow + 32 * i) * 128 + 8 * sseg); } \
        _Pragma("unroll") for (int i = 0; i < 4; ++i) sp[i] = *(const u32x4*)(Sprev + (size_t)un_ * 16384 + (size_t)(srow + 32 * i) * 128 + 8 * sseg); \
        const bf16* hgp_ = u + ((size_t)(bh_ >> 2) * SEQ + (size_t)c_ * 64 + nt) * AB_IN + 3072 + (bh_ & 3) * 128 + 16 * seg; \
        g0 = *(const bf16x8*)(hgp_); g1 = *(const bf16x8*)(hgp_ + 8); } while (0)
    if ((int)blockIdx.x < NHU) HC_LOAD(blockIdx.x);
    for (int unit = blockIdx.x; unit < NHU; unit += gridDim.x) {
        const int bh = unit >> 6, c = unit & 63, b = bh >> 2, h = bh & 3;
        const size_t row0 = (size_t)b * SEQ + (size_t)c * 64;
#pragma unroll
        for (int i = 0; i < 2; ++i) { *(LAS u32x4*)(qeT + (srow + 32 * i) * 136 + 8 * sseg) = sq[i]; *(LAS u32x4*)(inT + (srow + 32 * i) * 136 + 8 * sseg) = si[i]; }
#pragma unroll
        for (int i = 0; i < 4; ++i) *(LAS u32x4*)(spT + (srow + 32 * i) * 136 + 8 * sseg) = sp[i];
        const bf16x8 gc0 = g0, gc1 = g1;
        LDS_BARRIER();
        if (unit + (int)gridDim.x < NHU) HC_LOAD(unit + gridDim.x);
        f32x16 acc = zero16();
#pragma unroll
        for (int k8 = 0; k8 < 8; ++k8) acc = MFMA32(*(const LAS bf16x8*)(qeT + (32 * tblk + r32) * 136 + 16 * k8 + 8 * hi), *(const LAS bf16x8*)(spT + (32 * vblk + r32) * 136 + 16 * k8 + 8 * hi), acc);
#pragma unroll
        for (int r = 0; r < 16; ++r) { const int t = 32 * tblk + crow(r, hi), v = 32 * vblk + r32; ob[t * 132 + v] = acc[r] + bf2f(inT[t * 136 + v]); }
        LDS_BARRIER();
        { const int t = nt; float o[16]; float ss = 0.f;
#pragma unroll
          for (int i = 0; i < 16; i += 4) { const f32x4 q4 = *(const LAS f32x4*)(ob + t * 132 + 16 * seg + i); o[i] = q4.x; o[i + 1] = q4.y; o[i + 2] = q4.z; o[i + 3] = q4.w; ss += (q4.x * q4.x + q4.y * q4.y) + (q4.z * q4.z + q4.w * q4.w); }
          ss += __shfl_xor(ss, 1); ss += __shfl_xor(ss, 2); ss += __shfl_xor(ss, 4);
          const float rstd = rsqrtf(ss * (1.f / 128.f) + EPS);
          const float* gn = hg_norm + h * 128 + 16 * seg;
          unsigned w[8];
#pragma unroll
          for (int i = 0; i < 16; i += 2) { float y[2];
#pragma unroll
              for (int e2 = 0; e2 < 2; ++e2) { const int i2 = i + e2; const float hg = bf2f((bf16)(i2 < 8 ? gc0[i2 & 7] : gc1[i2 & 7])); const float sl = hg / (1.f + __expf(-hg)); y[e2] = o[i2] * rstd * gn[i2] * sl; }
              w[i >> 1] = cvtpk(y[0], y[1]); }
          bf16* yp = ycat + (row0 + t) * D + 512 + h * 128 + 16 * seg;
          *(u32x4*)(yp) = (u32x4){w[0], w[1], w[2], w[3]}; *(u32x4*)(yp + 8) = (u32x4){w[4], w[5], w[6], w[7]}; }
    }
#undef HC_LOAD
}

constexpr int AT_NSLOT = 7, AT_SLOT_ELEMS = 9216;
__device__ __forceinline__ void phase_attn(LAS unsigned char* lds, const bf16* Q, const bf16* K, const bf16* VT, bf16* O) {
    const int tid = threadIdx.x, lane = tid & 63, wid = tid >> 6, r32 = lane & 31, hi = lane >> 5;
    const int pr = (r32 & ~12) | ((r32 & 4) << 1) | ((r32 & 8) >> 1);
    LAS bf16* img = (LAS bf16*)lds;
    LAS int* flags = (LAS int*)(lds + AT_NSLOT * AT_SLOT_ELEMS * 2);
    const int srow = tid >> 3, sseg = tid & 7;
    for (int unit = blockIdx.x; unit < NHU; unit += gridDim.x) {
        const int bh = unit >> 4, qb = unit & 15, b = bh >> 4, h = bh & 15;
        const int q0 = qb * 256 + 32 * wid;
        const int mydiag = (q0 + 31) >> 6;
        const bf16* Ks = K + ((size_t)b * SEQ + srow) * D + h * 64 + 8 * sseg;
        const bf16* Vs = VT + ((size_t)bh * 64 + srow) * SEQ + 8 * sseg;
        bf16x8 qn[4];
#pragma unroll
        for (int d0 = 0; d0 < 4; ++d0) qn[d0] = *(const bf16x8*)(Q + ((size_t)b * SEQ + q0 + r32) * D + h * 64 + 16 * d0 + 8 * hi);
        float carry = 1.f; f32x16 o0 = zero16(), o1 = zero16();
        const int qpos = q0 + r32;
        bool wdone = false;
        for (int jbase = 4 * qb + 3; ; jbase -= AT_NSLOT) {
            const int nt = jbase + 1 < AT_NSLOT ? jbase + 1 : AT_NSLOT;
            {
                u32x4 kr[AT_NSLOT], vr[AT_NSLOT];
#pragma unroll
                for (int s = 0; s < AT_NSLOT; ++s) if (s < nt) { kr[s] = *(const u32x4*)(Ks + (size_t)(64 * (jbase - s)) * D); vr[s] = *(const u32x4*)(Vs + 64 * (jbase - s)); }
#pragma unroll
                for (int s = 0; s < AT_NSLOT; ++s) if (s < nt) { *(LAS u32x4*)(img + s * AT_SLOT_ELEMS + srow * 72 + 8 * sseg) = kr[s];
                    *(LAS u32x4*)(img + s * AT_SLOT_ELEMS + AT_SLOT_ELEMS / 2 + srow * 72 + 8 * sseg) = vr[s]; }
                __syncthreads();
            }
            if (!wdone) {
                const int jlo = jbase - nt + 1;
                for (int jt = (jbase < mydiag ? jbase : mydiag); jt >= jlo; --jt) {
                    const LAS bf16* Kt = img + (jbase - jt) * AT_SLOT_ELEMS; const LAS bf16* Vt = Kt + AT_SLOT_ELEMS / 2;
                    f32x16 p0 = zero16(), p1 = zero16();
#pragma unroll
                    for (int d0 = 0; d0 < 4; ++d0) { const bf16x8 a0 = *(const LAS bf16x8*)(Kt + pr * 72 + 16 * d0 + 8 * hi), a1 = *(const LAS bf16x8*)(Kt + (32 + pr) * 72 + 16 * d0 + 8 * hi);
                        p0 = MFMA32(a0, qn[d0], p0); p1 = MFMA32(a1, qn[d0], p1); }
                    const int kbase = 64 * jt + 8 * hi;
                    const bool diag = jt == mydiag;
#define VB(i, dh) (*(const LAS bf16x8*)(Vt + (32 * (dh) + r32) * 72 + 16 * (i) + 8 * hi))
#define AT_BETA(P, C, HF) do { \
                    _Pragma("unroll") for (int r = 0; r < 16; ++r) { C[r] = __builtin_amdgcn_rcpf(1.f + __builtin_amdgcn_exp2f(P[r])); P[r] = 1.f - C[r]; }     \
                    if (diag) { _Pragma("unroll") for (int r = 0; r < 16; ++r) { const int key = kbase + 32 * (HF) + 16 * (r >> 3) + (r & 7); if (key >= qpos) { C[r] = 1.f; P[r] = 0.f; } } } } while (0)
#define AT_TOT(C, T0, T1) do { T0 = ((C[0] * C[1]) * (C[2] * C[3])) * ((C[4] * C[5]) * (C[6] * C[7])); T1 = ((C[8] * C[9]) * (C[10] * C[11])) * ((C[12] * C[13]) * (C[14] * C[15])); } while (0)
                    float c1[16], c0[16], t10, t11, t00, t01;
                    AT_BETA(p1, c1, 1); AT_BETA(p0, c0, 0);
                    AT_TOT(c1, t10, t11); AT_TOT(c0, t00, t01);
                    const float u10 = __shfl_xor(t10, 32), u11 = __shfl_xor(t11, 32), u00 = __shfl_xor(t00, 32), u01 = __shfl_xor(t01, 32);
                    const float g1all1 = t11 * u11, T1 = (t10 * u10) * g1all1;
                    const float g1all0 = t01 * u01, T0 = (t00 * u00) * g1all0;
                    const float carry0 = carry * T1;
                    { float sa = (hi ? 1.f : u10) * g1all1 * carry, sb = (hi ? 1.f : u11) * carry, sc = (hi ? 1.f : u00) * g1all0 * carry0, sd = (hi ? 1.f : u01) * carry0;
                      _Pragma("unroll") for (int j = 7; j >= 0; --j) { p1[j] *= sa; sa *= c1[j]; p1[8 + j] *= sb; sb *= c1[8 + j]; p0[j] *= sc; sc *= c0[j]; p0[8 + j] *= sd; sd *= c0[8 + j]; } }
                    carry = carry0 * T0;
                    { const bf16x8 psA = pack8<0>(p1), psB = pack8<1>(p1), psC = pack8<0>(p0), psD = pack8<1>(p0);
                      o0 = MFMA32(psA, VB(2, 0), o0); o1 = MFMA32(psA, VB(2, 1), o1); o0 = MFMA32(psB, VB(3, 0), o0); o1 = MFMA32(psB, VB(3, 1), o1);
                      o0 = MFMA32(psC, VB(0, 0), o0); o1 = MFMA32(psC, VB(0, 1), o1); o0 = MFMA32(psD, VB(1, 0), o0); o1 = MFMA32(psD, VB(1, 1), o1); }
#undef AT_BETA
#undef AT_TOT
#undef VB
                    if (__all(carry == 0.f)) { wdone = true; break; }
                }
            }
            if (lane == 0) flags[wid] = wdone ? 1 : 0;
            __syncthreads();
            const int alld = flags[0] & flags[1] & flags[2] & flags[3] & flags[4] & flags[5] & flags[6] & flags[7];
            if (jbase - AT_NSLOT < 0 || alld) break;
        }
        { bf16* op = O + ((size_t)b * SEQ + q0) * D + h * 64 + r32;
#pragma unroll
          for (int r = 0; r < 16; ++r) { const int q = crow(r, hi); op[(size_t)q * D] = f2bf(o0[r]); op[(size_t)q * D + 32] = f2bf(o1[r]); } }
    }
}

struct Args { const float* in[17]; float* out; unsigned char* ws; int ph_lo, ph_hi; };
constexpr int N_PHASES = 14;

__global__ void __launch_bounds__(NTHR, 2) trunk_fwd(Args args) {
    extern __shared__ __attribute__((aligned(16))) unsigned char lds_raw[];
    LAS unsigned char* lds = (LAS unsigned char*)lds_raw;
    cg::grid_group grid = cg::this_grid();
    volatile LAS unsigned* misc = (volatile LAS unsigned*)(lds + LDS_MISC_OFF);
    if (threadIdx.x < 16) misc[threadIdx.x] = 0u;
    __syncthreads();
    XcdBarrier bar = xcd_barrier_post((unsigned*)(args.ws + WS_CTL), misc);
    unsigned char* ws = args.ws;
    const int lo = args.ph_lo, hi_ph = args.ph_hi;
#define IN(k) (lo <= (k) && (k) < hi_ph)
#ifndef USE_CG_SYNC
#define USE_CG_SYNC (args.ph_hi > 1000)
#endif
#define SEAM(k) do { if (IN(k) && IN((k) + 1)) { if (USE_CG_SYNC) grid.sync(); else xcd_barrier(bar); } } while (0)
    bf16* xres = (bf16*)(ws + WS_XRES);
    const float* mod = (const float*)(ws + WS_MOD);
    bf16* hbuf = (bf16*)(ws + WS_HBUF); bf16* ycat = (bf16*)(ws + WS_YCAT); bf16* big = (bf16*)(ws + WS_BIG);
    const int G = gridDim.x, bid = blockIdx.x;

    float* ssq_a = (float*)(ws + WS_SSQ); float* ssq_b = ssq_a + M; float* ssq_c = ssq_b + M;
    float* sw_up0 = (float*)(ws + WS_SW); float* sw_qkv = sw_up0 + 8 * FF; float* sw_up1 = sw_qkv + 8 * NQKV;
    const float* mod1 = mod + 8 * 6144;
    if (IN(0)) { phase_prologue(lds, args.in, ws); } SEAM(0);
    if (IN(1)) { phase_norm(args.in[0], args.in[4], mod + 0, mod + 1024, hbuf);
 } SEAM(1);
    if (IN(2)) { pg8::Gemm g{hbuf, (const bf16*)(ws + WS_WIN), M, AB_IN, D}; pg8::StaticOrder S; S.init(M, AB_IN, G, bid);
        pg8::EpiBf16<0> E{big, AB_IN, nullptr, 0, nullptr, EPS}; pg8::gemm_phase<pg8::EpiBf16<0>, pg8::StaticOrder, true, true>(lds, g, S, E); } SEAM(2);
    if (IN(3)) { phase_conv(big, args.in[7], ycat);
        phase_hgrn_a(lds, big, args.in[9], (bf16*)args.out  , (bf16*)(ws + WS_QE), (float*)(ws + WS_DLAST), (bf16*)(ws + WS_INTRA)); } SEAM(3);
    if (IN(4)) { phase_hgrn_scan((const bf16*)args.out, (const float*)(ws + WS_DLAST), hbuf  );
        for (int i = bid * NTHR + threadIdx.x; i < 3 * M; i += G * NTHR) ssq_a[i] = 0.f;
        phase_shiftw((const bf16*)(ws + WS_W1_0), FF, mod + 3072, sw_up0); phase_shiftw((const bf16*)(ws + WS_WQKV), NQKV, mod1 + 0, sw_qkv); phase_shiftw((const bf16*)(ws + WS_W1_1), FF, mod1 + 3072, sw_up1); } SEAM(4);
    if (IN(5)) { phase_hgrn_c(lds, big, (const bf16*)(ws + WS_QE), hbuf, (const bf16*)(ws + WS_INTRA), args.in[8], ycat); } SEAM(5);
    if (IN(6)) { pg8::Gemm g{ycat, (const bf16*)(ws + WS_WOUT), M, D, D}; pg8::StaticOrder S; S.init(M, D, G, bid);
        pg8::EpiResGate<false, true> E{args.in[0], xres, mod + 2048, 6144, hbuf, args.in[5], mod + 4096, ssq_a}; pg8::gemm_phase<pg8::EpiResGate<false, true>, pg8::StaticOrder, true, true>(lds, g, S, E); } SEAM(6);
    if (IN(7)) { pg8::Gemm g{hbuf, (const bf16*)(ws + WS_W1_0), M, FF, D}; pg8::StaticOrder S; S.init(M, FF, G, bid);
        pg8::EpiBf16<1> E{big, FF, sw_up0, FF, ssq_a, EPS}; pg8::gemm_phase<pg8::EpiBf16<1>, pg8::StaticOrder, true, true>(lds, g, S, E); } SEAM(7);
    if (IN(8)) { pg8::Gemm g{big, (const bf16*)(ws + WS_W2_0), M, D, FF}; pg8::StaticOrder S; S.init(M, D, G, bid);
        pg8::EpiResGate<true, true> E{xres, xres, mod + 5120, 6144, hbuf, args.in[4] + D, mod1 + 1024, ssq_b}; pg8::gemm_phase<pg8::EpiResGate<true, true>, pg8::StaticOrder, true, true>(lds, g, S, E); } SEAM(8);
    if (IN(9)) { pg8::Gemm g{hbuf, (const bf16*)(ws + WS_WQKV), M, NQKV, D}; pg8::StaticOrder S; S.init(M, NQKV, G, bid);
        pg8::EpiQKV E{big, (size_t)M * D, args.in[12], args.in[13], EPS, sw_qkv, NQKV, ssq_b}; pg8::gemm_phase<pg8::EpiQKV, pg8::StaticOrder, true, true>(lds, g, S, E); } SEAM(9);
    if (IN(10)) { phase_attn(lds, big, big + (size_t)M * D, big + (size_t)2 * M * D, ycat); } SEAM(10);
    if (IN(11)) { pg8::Gemm g{ycat, (const bf16*)(ws + WS_WOC), M, D, D}; pg8::StaticOrder S; S.init(M, D, G, bid);
        pg8::EpiResGate<true, true> E{xres, xres, mod1 + 2048, 6144, hbuf, args.in[5] + D, mod1 + 4096, ssq_c}; pg8::gemm_phase<pg8::EpiResGate<true, true>, pg8::StaticOrder, true, true>(lds, g, S, E); } SEAM(11);
    if (IN(12)) { pg8::Gemm g{hbuf, (const bf16*)(ws + WS_W1_1), M, FF, D}; pg8::StaticOrder S; S.init(M, FF, G, bid);
        pg8::EpiBf16<1> E{big, FF, sw_up1, FF, ssq_c, EPS}; pg8::gemm_phase<pg8::EpiBf16<1>, pg8::StaticOrder, true, true>(lds, g, S, E); } SEAM(12);
    if (IN(13)) { pg8::Gemm g{big, (const bf16*)(ws + WS_W2_1), M, D, FF}; pg8::StaticOrder S; S.init(M, D, G, bid);
        pg8::EpiResGate<true, false> E{xres, args.out, mod1 + 5120, 6144, nullptr, nullptr, nullptr, nullptr}; pg8::gemm_phase<pg8::EpiResGate<true, false>, pg8::StaticOrder, true, true>(lds, g, S, E); }
#undef IN
#undef SEAM
}

extern "C" void kernel_launch(void* const* d_in, const int* in_sizes, int n_in, void* d_out, int out_size, void* d_ws, size_t ws_size, hipStream_t stream) {
    static int grid = 0;
    if (grid == 0) {
        if (n_in != 17 || in_sizes[0] != M * D || out_size != M * D || ws_size < WS_END) {
            fprintf(stderr, "kernel_launch: unexpected shapes (n_in %d, in0 %d, out %d, ws %zu); nothing launched\n", n_in, n_in > 0 ? in_sizes[0] : -1, out_size, ws_size); grid = -1; return; }
        int dev = 0, cus = 0, per_cu = 0;
        if (hipGetDevice(&dev) != hipSuccess || hipDeviceGetAttribute(&cus, hipDeviceAttributeMultiprocessorCount, dev) != hipSuccess) { grid = -1; return; }
        if (hipFuncSetAttribute((const void*)trunk_fwd, hipFuncAttributeMaxDynamicSharedMemorySize, LDS_BYTES) != hipSuccess) { fprintf(stderr, "kernel_launch: hipFuncSetAttribute failed\n"); grid = -1; return; }
        if (hipOccupancyMaxActiveBlocksPerMultiprocessor(&per_cu, (const void*)trunk_fwd, NTHR, LDS_BYTES) != hipSuccess || per_cu < 1) { fprintf(stderr, "kernel_launch: occupancy query says %d\n", per_cu); per_cu = 1; }
        (void)hipGetLastError();
        grid = cus * per_cu;
    }
    if (grid < 0) return;
    if (hipMemsetAsync((char*)d_ws + WS_CTL, 0, CTL_ZERO_BYTES, stream) != hipSuccess) { fprintf(stderr, "kernel_launch: memset failed\n"); return; }
    Args a{};
    for (int i = 0; i < 17; ++i) a.in[i] = (const float*)d_in[i];
    a.out = (float*)d_out; a.ws = (unsigned char*)d_ws;
#if MK_N_LAUNCHES == 1
    a.ph_lo = 0; a.ph_hi = N_PHASES;
    void* kargs[] = {&a};
    hipError_t e = hipLaunchCooperativeKernel((const void*)trunk_fwd, dim3(grid), dim3(NTHR), kargs, LDS_BYTES, stream);
    if (e != hipSuccess) fprintf(stderr, "kernel_launch: cooperative launch failed: %s (grid %d)\n", hipGetErrorString(e), grid);
#else
    for (int p = 0; p < N_PHASES; ++p) { a.ph_lo = p; a.ph_hi = p + 1; hipLaunchKernelGGL(trunk_fwd, dim3(grid), dim3(NTHR), LDS_BYTES, stream, a); }
#endif
}
```
